# Optimizing an MI355X kernel written in HIP

```python
import math
import jax, jax.numpy as jnp
from jax import lax
import numpy as np

D_MODEL = 1024
BATCH = 4
SEQ = 4096
DEPTH = 2

GRID_W = 64
CTX_LEN = 256
HEAD_DIM = 64
QBLK = 128
ROPE_THETA = 10000.0
EPS = 1e-6
NEG_INF = -1e30

A_HEADS = 8
A_KV_HEADS = 2
B_HEADS = 8
B_KV_HEADS = 2
B_WINDOW = 128
AB_SIZES = (A_HEADS * HEAD_DIM, A_KV_HEADS * HEAD_DIM, A_KV_HEADS * HEAD_DIM,
            B_HEADS * HEAD_DIM, B_KV_HEADS * HEAD_DIM, B_KV_HEADS * HEAD_DIM)
AB_HEADS = (A_HEADS, A_KV_HEADS, A_KV_HEADS, B_HEADS, B_KV_HEADS, B_KV_HEADS)
AB_SPLITS = (512, 640, 768, 1280, 1408)
AB_IN = 1536
AB_OUT = (A_HEADS + B_HEADS) * HEAD_DIM

C_HEADS = 8
C_V_DIM = 2 * HEAD_DIM
C_QK_WIDTH = C_HEADS * 2 * HEAD_DIM
C_IN = 2 * C_QK_WIDTH + C_HEADS * C_V_DIM
C_OUT = C_HEADS * C_V_DIM

N_EXPERTS = 64
TOP_K = 8
N_GROUPS = 8
TOPK_GROUPS = 4
EXPERT_HIDDEN = 256
SHARED_HIDDEN = 256
ROUTED_SCALE = 2.5
EBLK = 128

N_EVEN = (DEPTH + 1) // 2
N_ODD = DEPTH // 2

kernel_name = "hybrid_dit_gqa_window_diffattn_moe"


def rms_norm(x, g):
    xf = x.astype(jnp.float32)
    y = xf * lax.rsqrt(jnp.mean(xf * xf, axis=-1, keepdims=True) + EPS)
    return y.astype(x.dtype) * g


def modulate(h, shift, scale):
    return h * (1 + scale) + shift


def axial_rope(rows, dtype):
    r = jnp.repeat(jnp.arange(rows, dtype=jnp.float32), GRID_W)
    col = jnp.tile(jnp.arange(GRID_W, dtype=jnp.float32), rows)
    n_pair = HEAD_DIM // 4
    inv = ROPE_THETA ** (-jnp.arange(n_pair, dtype=jnp.float32) / n_pair)
    ang = jnp.concatenate([r[:, None] * inv, col[:, None] * inv], axis=-1)
    return jnp.cos(ang).astype(dtype), jnp.sin(ang).astype(dtype)


def apply_rope(x, cos, sin):
    x1, x2 = x[..., 0::2], x[..., 1::2]
    c = cos[None, :, None, :]
    s = sin[None, :, None, :]
    return jnp.stack([x1 * c - x2 * s, x1 * s + x2 * c], axis=-1).reshape(x.shape)


def sweep_query_blocks(fn, q):
    b, n = q.shape[:2]
    nb = n // QBLK
    qb = q.reshape((b, nb, QBLK) + q.shape[2:]).swapaxes(0, 1)
    o = lax.map(fn, qb)
    return o.swapaxes(0, 1).reshape((b, n) + o.shape[3:])


def gqa_attend(q, k, v, sink=None, mask=None):
    b, nq, hq, d = q.shape
    hkv = k.shape[2]
    qg = q.reshape(b, nq, hkv, hq // hkv, d)
    s = jnp.einsum('bqhgd,bkhd->bhgqk', qg, k, preferred_element_type=jnp.float32) * (d ** -0.5)
    if mask is not None:
        s = jnp.where(mask, s, NEG_INF)
    if sink is not None:
        sk = jnp.broadcast_to(sink.astype(jnp.float32).reshape(hkv, hq // hkv)[None, :, :, None, None],
                              s.shape[:-1] + (1,))
        p = jax.nn.softmax(jnp.concatenate([s, sk], axis=-1), axis=-1)[..., :-1]
    else:
        p = jax.nn.softmax(s, axis=-1)
    o = jnp.einsum('bhgqk,bkhd->bqhgd', p.astype(v.dtype), v)
    return o.reshape(b, nq, hq * d)


def gqa_window_blocks(q, k, v, k_ctx, v_ctx, sink):
    b, n, hq, d = q.shape
    nb = n // QBLK
    lc = k_ctx.shape[1]
    pad = ((0, 0), (QBLK, QBLK), (0, 0), (0, 0))
    kp = jnp.pad(k, pad)
    vp = jnp.pad(v, pad)

    def one(i):
        q0 = i * QBLK
        qblk = lax.dynamic_slice_in_dim(q, q0, QBLK, axis=1)
        kb = lax.dynamic_slice_in_dim(kp, q0, 3 * QBLK, axis=1)
        vb = lax.dynamic_slice_in_dim(vp, q0, 3 * QBLK, axis=1)
        qpos = q0 + jnp.arange(QBLK)
        kpos = q0 - QBLK + jnp.arange(3 * QBLK)
        ok = (jnp.abs(qpos[:, None] - kpos[None, :]) <= B_WINDOW) & (kpos[None, :] >= 0) & (kpos[None, :] < n)
        mask = jnp.concatenate([jnp.ones((QBLK, lc), bool), ok], axis=1)
        return gqa_attend(qblk, jnp.concatenate([k_ctx, kb], axis=1),
                          jnp.concatenate([v_ctx, vb], axis=1), sink=sink, mask=mask)

    o = lax.map(one, jnp.arange(nb))
    return o.swapaxes(0, 1).reshape(b, n, hq * d)


def diff_attend(q, k, v, lam):
    d = q.shape[-1]
    s = jnp.einsum('bqhmd,bkhmd->bhmqk', q, k, preferred_element_type=jnp.float32) * (d ** -0.5)
    p = jax.nn.softmax(s, axis=-1)
    a = p[:, :, 0] - lam * p[:, :, 1]
    return jnp.einsum('bhqk,bkhe->bqhe', a.astype(v.dtype), v)


def mixer_ab(h_lat, h_ctx, w_in, w_out, q_norm, k_norm, sink, cos, sin, want_ctx):
    def project(h):
        b, n, _ = h.shape
        parts = jnp.split(h @ w_in, list(AB_SPLITS), axis=-1)
        qa, ka, va, qb, kb, vb = [p.reshape(b, n, hh, HEAD_DIM) for p, hh in zip(parts, AB_HEADS)]
        return rms_norm(qa, q_norm), rms_norm(ka, k_norm), va, qb, kb, vb

    qa, ka, va, qb, kb, vb = project(h_lat)
    qa, ka = apply_rope(qa, cos, sin), apply_rope(ka, cos, sin)
    qb, kb = apply_rope(qb, cos, sin), apply_rope(kb, cos, sin)
    qa_c, ka_c, va_c, qb_c, kb_c, vb_c = project(h_ctx)

    ka_all = jnp.concatenate([ka_c, ka], axis=1)
    va_all = jnp.concatenate([va_c, va], axis=1)
    oa = sweep_query_blocks(lambda qq: gqa_attend(qq, ka_all, va_all), qa)
    ob = gqa_window_blocks(qb, kb, vb, kb_c, vb_c, sink)
    o_lat = jnp.concatenate([oa, ob], axis=-1) @ w_out
    if want_ctx:
        oa_c = gqa_attend(qa_c, ka_c, va_c)
        ob_c = gqa_attend(qb_c, kb_c, vb_c, sink=sink)
        o_ctx = jnp.concatenate([oa_c, ob_c], axis=-1) @ w_out
    else:
        o_ctx = None
    return o_lat, o_ctx


def mixer_c(h_lat, h_ctx, w_in, w_out, lam_p, subln_g, cos, sin, lambda_init, want_ctx):
    def project(h):
        b, n, _ = h.shape
        q, k, v = jnp.split(h @ w_in, [C_QK_WIDTH, 2 * C_QK_WIDTH], axis=-1)
        return (q.reshape(b, n, C_HEADS, 2, HEAD_DIM), k.reshape(b, n, C_HEADS, 2, HEAD_DIM),
                v.reshape(b, n, C_HEADS, C_V_DIM))

    def rope2(t):
        b, n = t.shape[:2]
        return apply_rope(t.reshape(b, n, C_HEADS * 2, HEAD_DIM), cos, sin).reshape(t.shape)

    def finish(o):
        b, n = o.shape[:2]
        return (rms_norm(o, subln_g) * (1 - lambda_init)).reshape(b, n, C_OUT) @ w_out

    q, k, v = project(h_lat)
    q, k = rope2(q), rope2(k)
    qc, kc, vc = project(h_ctx)
    lp = lam_p.astype(jnp.float32)
    lam = jnp.exp(jnp.sum(lp[0] * lp[1])) - jnp.exp(jnp.sum(lp[2] * lp[3])) + lambda_init
    k_all = jnp.concatenate([kc, k], axis=1)
    v_all = jnp.concatenate([vc, v], axis=1)
    o_lat = finish(sweep_query_blocks(lambda qq: diff_attend(qq, k_all, v_all, lam), q))
    o_ctx = finish(diff_attend(qc, kc, vc, lam)) if want_ctx else None
    return o_lat, o_ctx


def moe(xt, router_w, router_bias, w1, w3, w2, sw1, sw3, sw2):
    t, d = xt.shape
    scores = jax.nn.sigmoid(xt.astype(jnp.float32) @ router_w.astype(jnp.float32))
    sel = scores + router_bias.astype(jnp.float32)
    group_score = lax.top_k(sel.reshape(t, N_GROUPS, N_EXPERTS // N_GROUPS), 2)[0].sum(-1)
    _, gidx = lax.top_k(group_score, TOPK_GROUPS)
    gmask = jax.nn.one_hot(gidx, N_GROUPS, dtype=jnp.float32).sum(1) > 0
    emask = jnp.repeat(gmask, N_EXPERTS // N_GROUPS, axis=1)
    _, idx = lax.top_k(jnp.where(emask, sel, NEG_INF), TOP_K)
    wts = jnp.take_along_axis(scores, idx, axis=1)
    wts = wts / jnp.sum(wts, axis=-1, keepdims=True) * ROUTED_SCALE

    flat_e = idx.reshape(-1)
    order = jnp.argsort(flat_e)
    sorted_e = flat_e[order]
    sorted_tok = order // TOP_K
    sorted_w = wts.reshape(-1)[order]
    counts = jnp.bincount(flat_e, length=N_EXPERTS)
    padded = (counts + EBLK - 1) // EBLK * EBLK
    pad_end = jnp.cumsum(padded)
    pad_start = pad_end - padded
    start = jnp.cumsum(counts) - counts
    dest = pad_start[sorted_e] + jnp.arange(t * TOP_K) - start[sorted_e]
    n_blocks = -(-(t * TOP_K) // EBLK) + N_EXPERTS
    n_slots = n_blocks * EBLK
    slot_tok = jnp.full((n_slots,), t, jnp.int32).at[dest].set(sorted_tok.astype(jnp.int32))
    slot_w = jnp.zeros((n_slots,), xt.dtype).at[dest].set(sorted_w.astype(xt.dtype))
    block_e = jnp.minimum(jnp.searchsorted(pad_end, jnp.arange(n_blocks) * EBLK, side='right'),
                          N_EXPERTS - 1)
    xpad = jnp.concatenate([xt, jnp.zeros((1, d), xt.dtype)], axis=0)

    def expert_block(args):
        tok, e = args
        xb = xpad[tok]
        h = jax.nn.silu(xb @ w1[e]) * (xb @ w3[e])
        return h @ w2[e]

    yb = lax.map(expert_block, (slot_tok.reshape(n_blocks, EBLK), block_e))
    routed = jnp.zeros((t + 1, d), xt.dtype).at[slot_tok].add(yb.reshape(n_slots, d) * slot_w[:, None])[:t]
    shared = (jax.nn.silu(xt @ sw1) * (xt @ sw3)) @ sw2
    return routed + shared


def setup_inputs(seed: int = 0) -> dict:
    key = jax.random.key(seed)
    ks = jax.random.split(key, 26)
    f32 = jnp.float32

    def nrm(k, shape, fan_in, gain=1.0):
        return jax.random.normal(k, shape, f32) * (gain * fan_in ** -0.5)

    def gain(k, shape):
        return 1.0 + 0.05 * jax.random.normal(k, shape, f32)

    return {
        "x": jax.random.normal(ks[0], (BATCH, SEQ, D_MODEL), f32),
        "c": jax.random.normal(ks[1], (BATCH, D_MODEL), f32),
        "ctx": jax.random.normal(ks[2], (BATCH, CTX_LEN, D_MODEL), f32),
        "c_ctx": jax.random.normal(ks[3], (D_MODEL,), f32),
        "ada_w": nrm(ks[4], (DEPTH, D_MODEL, 6 * D_MODEL), D_MODEL, 0.5),
        "ada_b": 0.02 * jax.random.normal(ks[5], (DEPTH, 6 * D_MODEL), f32),
        "norm_g": gain(ks[6], (DEPTH, 4, D_MODEL)),
        "ab_w_in": nrm(ks[7], (N_EVEN, D_MODEL, AB_IN), D_MODEL),
        "ab_w_out": nrm(ks[8], (N_EVEN, AB_OUT, D_MODEL), AB_OUT),
        "a_q_norm": gain(ks[9], (N_EVEN, HEAD_DIM)),
        "a_k_norm": gain(ks[10], (N_EVEN, HEAD_DIM)),
        "b_sink": 0.5 * jax.random.normal(ks[11], (N_EVEN, B_HEADS), f32),
        "c_w_in": nrm(ks[12], (N_ODD, D_MODEL, C_IN), D_MODEL),
        "c_w_out": nrm(ks[13], (N_ODD, C_OUT, D_MODEL), C_OUT),
        "c_lambda": 0.1 * jax.random.normal(ks[14], (N_ODD, 4, HEAD_DIM), f32),
        "c_subln_g": gain(ks[15], (N_ODD, C_V_DIM)),
        "router_w": nrm(ks[16], (DEPTH, D_MODEL, N_EXPERTS), D_MODEL),
        "router_bias": 0.01 * jax.random.normal(ks[17], (DEPTH, N_EXPERTS), f32),
        "exp_w1": nrm(ks[18], (DEPTH, N_EXPERTS, D_MODEL, EXPERT_HIDDEN), D_MODEL),
        "exp_w3": nrm(ks[19], (DEPTH, N_EXPERTS, D_MODEL, EXPERT_HIDDEN), D_MODEL),
        "exp_w2": nrm(ks[20], (DEPTH, N_EXPERTS, EXPERT_HIDDEN, D_MODEL), EXPERT_HIDDEN),
        "sh_w1": nrm(ks[21], (DEPTH, D_MODEL, SHARED_HIDDEN), D_MODEL),
        "sh_w3": nrm(ks[22], (DEPTH, D_MODEL, SHARED_HIDDEN), D_MODEL),
        "sh_w2": nrm(ks[23], (DEPTH, SHARED_HIDDEN, D_MODEL), SHARED_HIDDEN),
    }


def reference(x, c, ctx, c_ctx, ada_w, ada_b, norm_g, ab_w_in, ab_w_out, a_q_norm, a_k_norm, b_sink,
              c_w_in, c_w_out, c_lambda, c_subln_g, router_w, router_bias, exp_w1, exp_w3, exp_w2,
              sh_w1, sh_w3, sh_w2):
    b, n, d = x.shape
    rows = n // GRID_W
    cos, sin = axial_rope(rows, x.dtype)
    sc = jax.nn.silu(c)
    scc = jax.nn.silu(c_ctx)
    x_lat, x_ctx = x, ctx
    lc = ctx.shape[1]

    for l in range(DEPTH):
        last = l == DEPTH - 1
        mod = sc @ ada_w[l] + ada_b[l]
        mod_c = scc @ ada_w[l] + ada_b[l]
        sh1, s1, g1, sh2, s2, g2 = jnp.split(mod[:, None, :], 6, axis=-1)
        csh1, cs1, cg1, csh2, cs2, cg2 = jnp.split(mod_c, 6, axis=-1)

        h_lat = modulate(rms_norm(x_lat, norm_g[l, 0]), sh1, s1)
        h_ctx = modulate(rms_norm(x_ctx, norm_g[l, 0]), csh1, cs1)
        j = l // 2
        if l % 2 == 0:
            o_lat, o_ctx = mixer_ab(h_lat, h_ctx, ab_w_in[j], ab_w_out[j], a_q_norm[j], a_k_norm[j],
                                    b_sink[j], cos, sin, not last)
        else:
            lambda_init = 0.8 - 0.6 * math.exp(-0.3 * l)
            o_lat, o_ctx = mixer_c(h_lat, h_ctx, c_w_in[j], c_w_out[j], c_lambda[j], c_subln_g[j],
                                   cos, sin, lambda_init, not last)
        x_lat = x_lat + g1 * rms_norm(o_lat, norm_g[l, 1])
        if not last:
            x_ctx = x_ctx + cg1 * rms_norm(o_ctx, norm_g[l, 1])

        h_lat = modulate(rms_norm(x_lat, norm_g[l, 2]), sh2, s2).reshape(b * n, d)
        if not last:
            h_ctx = modulate(rms_norm(x_ctx, norm_g[l, 2]), csh2, cs2).reshape(b * lc, d)
            y = moe(jnp.concatenate([h_ctx, h_lat], axis=0), router_w[l], router_bias[l], exp_w1[l],
                    exp_w3[l], exp_w2[l], sh_w1[l], sh_w3[l], sh_w2[l])
            y_ctx = y[:b * lc].reshape(b, lc, d)
            y_lat = y[b * lc:].reshape(b, n, d)
            x_ctx = x_ctx + cg2 * rms_norm(y_ctx, norm_g[l, 3])
        else:
            y_lat = moe(h_lat, router_w[l], router_bias[l], exp_w1[l], exp_w3[l], exp_w2[l],
                        sh_w1[l], sh_w3[l], sh_w2[l]).reshape(b, n, d)
        x_lat = x_lat + g2 * rms_norm(y_lat, norm_g[l, 3])

    return x_lat
```

```cpp
#include <hip/hip_runtime.h>
#include <stdint.h>
#include <stdio.h>

#ifndef N_LAUNCH_PER_PHASE
#define N_LAUNCH_PER_PHASE 0
#endif

#define LAS __attribute__((address_space(3)))
typedef unsigned short bf16_t;
typedef unsigned char uchar;
typedef short bf16x8 __attribute__((ext_vector_type(8)));
typedef short s16x4 __attribute__((ext_vector_type(4)));
typedef short v4i16_t __attribute__((ext_vector_type(4)));
typedef float f32x2 __attribute__((ext_vector_type(2)));
typedef float f32x4 __attribute__((ext_vector_type(4)));
typedef float f32x16 __attribute__((ext_vector_type(16)));
typedef unsigned u32x2 __attribute__((ext_vector_type(2)));
typedef unsigned u32x4 __attribute__((ext_vector_type(4)));
typedef int i32x4 __attribute__((ext_vector_type(4)));
typedef int i32x8 __attribute__((ext_vector_type(8)));

constexpr int DM = 1024, NBATCH = 4, SEQ = 4096, LCTX = 256, NPOS = LCTX + SEQ;
constexpr int TCTX = NBATCH * LCTX, TLAT = NBATCH * SEQ, TT = TCTX + TLAT;
constexpr int NSLOT_R = TT * 8;
constexpr float EPS = 1e-6f, LOG2E = 1.4426950408889634f, QSCALE = 0.125f * 1.4426950408889634f;
constexpr float LAMBDA_INIT = 0.35550906759f;
constexpr float Q_QS = 32.0f, K_QS = 4.0f;
constexpr int Q_E8M0 = 0x7A7A7A7A, K_E8M0 = 0x7D7D7D7D;
constexpr float V_QS = 4.0f, P_QS = 16.0f;
constexpr int V_E8M0 = 0x7D7D7D7D, P_E8M0 = 0x7B7B7B7B;
constexpr float P_OFF = 4.0f;
constexpr float ATT_THR = 4.0f;

constexpr size_t al4k(size_t x) { return (x + 4095) & ~(size_t)4095; }
constexpr size_t CNT_OFF = 16 * 16384, CNT_SET = 2 * 16 * 64 * 64, ADA_CTR_OFF = CNT_OFF + 2 * CNT_SET, CTL_BYTES = ADA_CTR_OFF + 1024;
constexpr int LCAP = TT / 16;
constexpr size_t WS_MOD = CTL_BYTES;
constexpr size_t WS_ADAP = WS_MOD + al4k((size_t)2 * 5 * 6144 * 4);
constexpr size_t WS_ROPE = WS_ADAP + al4k((size_t)192 * 8 * 5 * 64 * 4);
constexpr size_t WS_LAM = WS_ROPE + 8192;
constexpr size_t WS_WD = WS_LAM + 4096;
constexpr size_t WD_ABIN = 0, WD_ABOUT = (size_t)1536 * 1024 * 2, WD_CIN = WD_ABOUT + (size_t)1024 * 1024 * 2, WD_COUT = WD_CIN + (size_t)3072 * 1024 * 2,
                 WD_BYTES = WD_COUT + (size_t)1024 * 1024 * 2;
constexpr size_t WS_RW = WS_WD + WD_BYTES;
constexpr size_t WS_WE = WS_RW + (size_t)2 * 64 * 1024 * 2;
constexpr size_t WE_STRIDE = (size_t)512 * 1024 + (size_t)1024 * 256;
constexpr float W13_QS = 64.0f, W2_QS = 32.0f, H2_QS = 4.0f, HMID_QS = 8.0f;
constexpr size_t WS_XB = WS_WE + 65 * WE_STRIDE;
constexpr size_t WS_LIST = WS_XB + (size_t)TT * DM * 2;
constexpr size_t WS_SLOTW = WS_LIST + (size_t)64 * TT * 4;
constexpr size_t WS_TRASH = al4k(WS_SLOTW + (size_t)NSLOT_R * 4);
constexpr size_t WS_BIG = WS_TRASH + 4096;
constexpr size_t ACT_B = (size_t)TT * DM * 2;
constexpr size_t BIG_YK = 0, BIG_YSH = 5 * ACT_B, BIG_HMID = BIG_YSH + ACT_B, BIG_BYTES = BIG_HMID + 2 * ACT_B;
constexpr size_t WS_TOTAL = WS_BIG + BIG_BYTES;
constexpr size_t L0_ACT = 0, L0_QA = ACT_B, L0_QB = L0_QA + (size_t)TT * 512 * 2, L0_KA = L0_QB + (size_t)TT * 512 * 2;
constexpr size_t KV64_B = (size_t)NBATCH * 2 * NPOS * 64 * 2;
constexpr size_t L0_VA = L0_KA + KV64_B, L0_KB = L0_VA + KV64_B, L0_VB = L0_KB + KV64_B, L0_PO = L0_VB + KV64_B;
constexpr size_t L1_H = BIG_HMID, L1_QC = 0, L1_KC = ACT_B, L1_VC = 2 * ACT_B, L1_O = 3 * ACT_B, L1_PO = 4 * ACT_B;
constexpr size_t L0_H2 = BIG_HMID, L1_H2 = BIG_HMID + ACT_B;
static_assert(L0_PO + ACT_B <= BIG_YSH && 5 * ACT_B <= BIG_YSH && L1_H2 + ACT_B <= BIG_BYTES && (size_t)NSLOT_R * DM <= BIG_YSH, "aliases must stay inside the Yk region");

constexpr int LDS_SMALL = 4 * 32768, LDS_BAR = LDS_SMALL + 8192, LDS_BYTES = LDS_BAR + 16;
constexpr int RT_STRIDE = 1028;

struct Params { const float* in[24]; float* out; uchar* ws; int ph_lo, ph_hi; size_t dbg_off, dbg_bytes; size_t bar_off; };

#define XB_TMO      128
#define XB_XCNT(j)  (256  + 64 * (j))
#define XB_XSUB(j)  (1280 + 64 * (j))
#define XB_XGEN(j)  (2304 + 64 * (j))
#define XB_TOP      3328
#define XB_TOPGEN   3392
#define XCD_BAR_WORDS 3456
#define XB_SPIN_CAP (1u << 18)
__device__ __forceinline__ unsigned xb_ld(unsigned* p)              { return __hip_atomic_load(p, __ATOMIC_RELAXED, __HIP_MEMORY_SCOPE_AGENT); }
__device__ __forceinline__ unsigned xb_add(unsigned* p, unsigned v) { return __hip_atomic_fetch_add(p, v, __ATOMIC_RELAXED, __HIP_MEMORY_SCOPE_AGENT); }
__device__ __forceinline__ unsigned xb_xcc_id() { return (unsigned)__builtin_amdgcn_s_getreg((3 << 11) | 20) & 0xFu; }
#define XB_SPIN(cond, bar) do { unsigned _sp = 0; while (cond) { __builtin_amdgcn_s_sleep(1); \
    if ((++_sp & 255u) == 0u) { if (xb_ld(&(bar)[XB_TMO])) break; if (_sp > XB_SPIN_CAP) { atomicAdd(&(bar)[XB_TMO], 1u); break; } } } } while (0)
struct XcdBarrier { unsigned* bar; unsigned x; volatile LAS unsigned* st; };
__device__ __forceinline__ XcdBarrier xcd_barrier_post(unsigned* bar, volatile LAS unsigned* st) {
    XcdBarrier b; b.bar = bar; b.x = xb_xcc_id(); b.st = st;
    if (threadIdx.x == 0) (void)xb_add(&bar[XB_XCNT(b.x)], 1u);
    return b;
}
__device__ __forceinline__ void xcd_barrier_complete(unsigned* bar, unsigned x, unsigned& nloc, unsigned& nx) {
    const unsigned G = gridDim.x * gridDim.y * gridDim.z;
    unsigned sum, cnt, mine, sp = 0u;
    for (;;) {
        sum = 0u; cnt = 0u; mine = 0u;
#pragma unroll
        for (unsigned j = 0; j < 16; ++j) { const unsigned c = xb_ld(&bar[XB_XCNT(j)]); sum += c; cnt += (c > 0u) ? 1u : 0u; mine = (j == x) ? c : mine; }
        if (sum == G) break;
        __builtin_amdgcn_s_sleep(1);
        if ((++sp & 255u) == 0u) { if (xb_ld(&bar[XB_TMO])) break; if (sp > XB_SPIN_CAP) { atomicAdd(&bar[XB_TMO], 1u); break; } }
    }
    nloc = mine > 0u ? mine : 1u; nx = cnt > 0u ? cnt : 1u;
}
__device__ __forceinline__ void xcd_barrier(const XcdBarrier& b) {
    asm volatile("s_waitcnt vmcnt(0)" ::: "memory");
    __syncthreads();
    if (threadIdx.x == 0) {
        unsigned* bar = b.bar;
        __builtin_amdgcn_s_waitcnt(0);
        unsigned nloc = b.st[0], nx = b.st[1];
        if (nloc == 0u) { xcd_barrier_complete(bar, b.x, nloc, nx); b.st[0] = nloc; b.st[1] = nx; }
        const unsigned old = xb_add(&bar[XB_XSUB(b.x)], 1u);
        const unsigned gen = old / nloc;
        if (old + 1u == (gen + 1u) * nloc) {
            __builtin_amdgcn_fence(__ATOMIC_RELEASE, "agent");
            asm volatile("s_waitcnt vmcnt(0)" ::: "memory");
            const unsigned og = xb_add(&bar[XB_TOP], 1u);
            const unsigned tg = og / nx;
            if (og + 1u == (tg + 1u) * nx) xb_add(&bar[XB_TOPGEN], 1u);
            else XB_SPIN(xb_ld(&bar[XB_TOPGEN]) == tg, bar);
            __builtin_amdgcn_fence(__ATOMIC_ACQUIRE, "agent");
            xb_add(&bar[XB_XGEN(b.x)], 1u);
            asm volatile("s_waitcnt vmcnt(0)" ::: "memory");
        } else {
            XB_SPIN(xb_ld(&bar[XB_XGEN(b.x)]) == gen, bar);
            __builtin_amdgcn_fence(__ATOMIC_ACQUIRE, "agent");
            asm volatile("s_waitcnt vmcnt(0)" ::: "memory");
        }
    }
    __syncthreads();
}

#define MFMA32(a, b, c) __builtin_amdgcn_mfma_f32_32x32x16_bf16(a, b, c, 0, 0, 0)
typedef __bf16 bf16x2_t __attribute__((ext_vector_type(2)));
__device__ __forceinline__ unsigned cvt_pk(float lo, float hi) { const f32x2 f = {lo, hi}; return __builtin_bit_cast(unsigned, __builtin_convertvector(f, bf16x2_t)); }
__device__ __forceinline__ float bf_lo(unsigned w) { return __uint_as_float(w << 16); }
__device__ __forceinline__ float clamp_fp8(float x) { return __builtin_fminf(__builtin_fmaxf(x, -448.0f), 448.0f); }
__device__ __forceinline__ unsigned pk_fp8x4(float a, float b, float c, float d) {
    int w = __builtin_amdgcn_cvt_pk_fp8_f32(clamp_fp8(a), clamp_fp8(b), 0, false);
    return (unsigned)__builtin_amdgcn_cvt_pk_fp8_f32(clamp_fp8(c), clamp_fp8(d), w, true); }
__device__ __forceinline__ unsigned pk_fp8x4_nc(float a, float b, float c, float d) {
    int w = __builtin_amdgcn_cvt_pk_fp8_f32(a, b, 0, false);
    return (unsigned)__builtin_amdgcn_cvt_pk_fp8_f32(c, d, w, true); }
__device__ __forceinline__ f32x4 fp8x4_f32(unsigned w) {
    const auto lo = __builtin_amdgcn_cvt_pk_f32_fp8((int)w, false), hi = __builtin_amdgcn_cvt_pk_f32_fp8((int)w, true);
    return (f32x4){lo[0], lo[1], hi[0], hi[1]}; }
__device__ __forceinline__ float bf_hi(unsigned w) { return __uint_as_float(w & 0xffff0000u); }
__device__ __forceinline__ float wsum(float v) {
#pragma unroll
    for (int o = 32; o > 0; o >>= 1) v += __shfl_xor(v, o);
    return v; }
__device__ __forceinline__ float wmaxf(float v) {
#pragma unroll
    for (int o = 32; o > 0; o >>= 1) v = fmaxf(v, __shfl_xor(v, o));
    return v; }
__device__ __forceinline__ int crow(int r, int h) { return (r & 3) + 8 * (r >> 2) + 4 * h; }
__device__ __forceinline__ void dma16(const void* g, LAS uchar* lds_wave_base) {
    unsigned sv; const unsigned dst = (unsigned)__builtin_amdgcn_readfirstlane((int)(unsigned)(uintptr_t)lds_wave_base);
    asm volatile("s_mov_b32 %0, m0\n\ts_mov_b32 m0, %2\n\ts_nop 0\n\tglobal_load_lds_dwordx4 %1, off\n\ts_mov_b32 m0, %0" : "=&s"(sv) : "v"(g), "s"(dst) : "memory"); }
__device__ __forceinline__ void dma16nt(const void* g, LAS uchar* lds_wave_base) {
    __builtin_amdgcn_global_load_lds((const unsigned*)g, (LAS unsigned*)lds_wave_base, 16, 0, 2); }
__device__ __forceinline__ float siluf(float x) { return x / (1.0f + expf(-x)); }
__device__ __forceinline__ f32x4 ld4(const float* p) { return *(const f32x4*)p; }
__device__ __forceinline__ f32x4 ldbf4(const bf16_t* p) { const u32x2 w = *(const u32x2*)p; return (f32x4){bf_lo(w.x), bf_hi(w.x), bf_lo(w.y), bf_hi(w.y)}; }
__device__ __forceinline__ void stbf4(bf16_t* p, f32x4 v) { u32x2 w; w.x = cvt_pk(v[0], v[1]); w.y = cvt_pk(v[2], v[3]); *(u32x2*)p = w; }
__device__ __forceinline__ int mod_row(int row) { return row < TCTX ? 4 : (row - TCTX) >> 12; }

struct ConvDesc { const float* src; bf16_t* lo; bf16_t* hi; int ldn, ldk; uchar* qlo; uchar* qhi; float qs; };
__device__ __forceinline__ void conv_load(const ConvDesc& d, f32x4 (&v)[2][8], int lane) {
    const int n4 = lane & 15, q = lane >> 4;
#pragma unroll
    for (int half = 0; half < 2; ++half)
#pragma unroll
        for (int i = 0; i < 8; ++i) v[half][i] = __builtin_nontemporal_load((const f32x4*)(d.src + (size_t)(32 * half + 8 * q + i) * d.ldn + 4 * n4));
}
__device__ __forceinline__ void conv_store(const ConvDesc& d, const f32x4 (&v)[2][8], int lane) {
    const int n4 = lane & 15, q = lane >> 4;
#pragma unroll
    for (int half = 0; half < 2; ++half) {
        const int kb = 32 * half + 8 * q;
#pragma unroll
        for (int j = 0; j < 4; ++j) {
            const int n = 4 * n4 + j;
            bf16_t* drow = (n < 32) ? d.lo + (size_t)n * d.ldk : d.hi + (size_t)(n - 32) * d.ldk;
            u32x4 w; w.x = cvt_pk(v[half][0][j], v[half][1][j]); w.y = cvt_pk(v[half][2][j], v[half][3][j]); w.z = cvt_pk(v[half][4][j], v[half][5][j]); w.w = cvt_pk(v[half][6][j], v[half][7][j]);
            *(u32x4*)(drow + kb) = w;
        }
    }
}
__device__ __forceinline__ void conv_store_q8(const ConvDesc& d, const f32x4 (&v)[2][8], int lane) {
    const int n4 = lane & 15, q = lane >> 4; const float qs = d.qs;
#pragma unroll
    for (int half = 0; half < 2; ++half) {
        const int kb = 32 * half + 8 * q;
#pragma unroll
        for (int j = 0; j < 4; ++j) {
            const int n = 4 * n4 + j;
            uchar* drow = (n < 32) ? d.qlo + (size_t)n * d.ldk : d.qhi + (size_t)(n - 32) * d.ldk;
            u32x2 w; w.x = pk_fp8x4(v[half][0][j] * qs, v[half][1][j] * qs, v[half][2][j] * qs, v[half][3][j] * qs);
            w.y = pk_fp8x4(v[half][4][j] * qs, v[half][5][j] * qs, v[half][6][j] * qs, v[half][7][j] * qs);
            *(u32x2*)(drow + kb) = w;
        }
    }
}
__device__ __forceinline__ void conv_tile(const float* src, int ldn, int k0, int n0, bf16_t* dst_lo, bf16_t* dst_hi, int ldk, int lane) {
    ConvDesc d; d.src = src + (size_t)k0 * ldn + n0; d.lo = dst_lo + k0; d.hi = dst_hi + k0; d.ldn = ldn; d.ldk = ldk; d.qlo = nullptr; d.qhi = nullptr; d.qs = 0.f;
    f32x4 v[2][8];
    conv_load(d, v, lane); conv_store(d, v, lane);
}
__device__ __forceinline__ void conv_expert_desc(const Params& p, int l, int t, ConvDesc& d) {
    const int e = t / 192, ti = t % 192, part = ti >> 6, r = ti & 63;
    uchar* we = p.ws + WS_WE + (size_t)e * WE_STRIDE;
    d.lo = nullptr; d.hi = nullptr;
    if (part < 2) {
        const float* src = (e < 64) ? p.in[part == 0 ? 18 : 19] + ((size_t)(l * 64 + e) << 18) : p.in[part == 0 ? 21 : 22] + ((size_t)l << 18);
        const int kt = r >> 2, nt = r & 3;
        uchar* lo = we + (size_t)(128 * nt + (part ? 32 : 0)) * 1024;
        d.src = src + (size_t)(kt * 64) * 256 + nt * 64; d.qlo = lo + kt * 64; d.qhi = lo + 64 * 1024 + kt * 64; d.ldn = 256; d.ldk = 1024; d.qs = W13_QS;
    } else {
        const float* src = (e < 64) ? p.in[20] + ((size_t)(l * 64 + e) << 18) : p.in[23] + ((size_t)l << 18);
        const int kt = r >> 4, nt = r & 15;
        uchar* lo = we + (size_t)512 * 1024 + (size_t)(64 * nt) * 256;
        d.src = src + (size_t)(kt * 64) * 1024 + nt * 64; d.qlo = lo + kt * 64; d.qhi = lo + 32 * 256 + kt * 64; d.ldn = 1024; d.ldk = 256; d.qs = W2_QS;
    }
}
__device__ __forceinline__ void conv_dense_task(const Params& p, int t, int lane) {
    const float* src; int N; size_t off;
    if (t < 384) { src = p.in[7]; N = 1536; off = WD_ABIN; }
    else if (t < 640) { t -= 384; src = p.in[8]; N = 1024; off = WD_ABOUT; }
    else if (t < 1408) { t -= 640; src = p.in[12]; N = 3072; off = WD_CIN; }
    else { t -= 1408; src = p.in[13]; N = 1024; off = WD_COUT; }
    const int ntn = N / 64, kt = t / ntn, nt = t % ntn;
    bf16_t* lo = (bf16_t*)(p.ws + WS_WD + off) + (size_t)(64 * nt) * 1024;
    conv_tile(src, N, kt * 64, nt * 64, lo, lo + 32 * 1024, 1024, lane);
}
#define rlf0(v, l) __uint_as_float((unsigned)__builtin_amdgcn_readlane((int)__float_as_uint(v), (l)))
__device__ __forceinline__ void ada_task(const Params& p, int t, int lane) {
    const int kq = t & 7, lc = t >> 3, l = lc / 96, cg = lc % 96, col = cg * 64 + lane;
    const float* W = p.in[4] + (size_t)l * 1024 * 6144 + col;
    float acc[5] = {0.f, 0.f, 0.f, 0.f, 0.f};
#pragma unroll 1
    for (int kb = kq * 2; kb < kq * 2 + 2; ++kb) {
        float wv[64];
#pragma unroll
        for (int j = 0; j < 64; ++j) wv[j] = __builtin_nontemporal_load(W + (size_t)(kb * 64 + j) * 6144);
        float s[5];
#pragma unroll
        for (int r = 0; r < 4; ++r) s[r] = siluf(p.in[1][r * 1024 + kb * 64 + lane]);
        s[4] = siluf(p.in[3][kb * 64 + lane]);
        __builtin_amdgcn_sched_barrier(0);
#pragma unroll
        for (int j = 0; j < 64; ++j) {
#pragma unroll
            for (int r = 0; r < 5; ++r) acc[r] += rlf0(s[r], j) * wv[j];
        }
    }
    float* part = (float*)(p.ws + WS_ADAP) + ((size_t)(lc * 8 + kq) * 5) * 64 + lane;
#pragma unroll
    for (int r = 0; r < 5; ++r) __hip_atomic_store(part + r * 64, acc[r], __ATOMIC_RELAXED, __HIP_MEMORY_SCOPE_AGENT);
    asm volatile("s_waitcnt vmcnt(0)" ::: "memory");
    unsigned tick = 0;
    if (lane == 0) tick = __hip_atomic_fetch_add((unsigned*)(p.ws + ADA_CTR_OFF) + lc, 1u, __ATOMIC_RELAXED, __HIP_MEMORY_SCOPE_AGENT);
    tick = (unsigned)__builtin_amdgcn_readfirstlane((int)tick);
    if (tick == 7u) {
        float* mod = (float*)(p.ws + WS_MOD) + (size_t)l * 5 * 6144;
        const float bb = p.in[5][l * 6144 + col];
        const float* pb4 = (const float*)(p.ws + WS_ADAP) + ((size_t)(lc * 8) * 5) * 64 + lane;
#pragma unroll
        for (int r = 0; r < 5; ++r) { float a = bb;
#pragma unroll
            for (int q = 0; q < 8; ++q) a += __hip_atomic_load(pb4 + (q * 5 + r) * 64, __ATOMIC_RELAXED, __HIP_MEMORY_SCOPE_AGENT);
            __hip_atomic_store(mod + r * 6144 + col, a, __ATOMIC_RELAXED, __HIP_MEMORY_SCOPE_AGENT); }
        asm volatile("s_waitcnt vmcnt(0)" ::: "memory");
        if (lane == 0) __hip_atomic_fetch_add((unsigned*)(p.ws + ADA_CTR_OFF) + 240, 1u, __ATOMIC_RELAXED, __HIP_MEMORY_SCOPE_AGENT);
    }
}
__device__ __forceinline__ void misc_task(const Params& p, int i, int lane) {
    if (i < 16) {
        float* ct = (float*)(p.ws + WS_ROPE); float* st = ct + 1024;
        const int idx = lane + 64 * i, pos = idx >> 4, fi = idx & 15;
        const float inv = powf(10000.0f, -(float)fi / 16.0f), ang = (float)pos * inv;
        ct[idx] = cosf(ang); st[idx] = sinf(ang);
        return;
    }
    const float* lp = p.in[14];
    const float a = wsum(lp[lane] * lp[64 + lane]), b = wsum(lp[128 + lane] * lp[192 + lane]);
    if (lane == 0) *(float*)(p.ws + WS_LAM) = expf(a) - expf(b) + LAMBDA_INIT;
}
constexpr int CONV_T = 65 * 192, CV_A0 = 104 * 8 * 4, CV_B0 = CV_A0 + 224 * 8 * 1, CV_A1 = 160 * 8 * 2;
__device__ __forceinline__ void conv_strided(const Params& p, int l, int tbase, int w, int stride, int n, int tend, int lane) {
    for (int i = 0; i < n; i += 2) {
        const int t0 = tbase + w + i * stride, t1 = t0 + stride; const bool b0 = t0 < tend, b1 = (i + 1 < n) && t1 < tend;
        ConvDesc da, db; f32x4 va[2][8], vb[2][8];
        if (b0) { conv_expert_desc(p, l, t0, da); conv_load(da, va, lane); }
        if (b1) { conv_expert_desc(p, l, t1, db); conv_load(db, vb, lane); }
        if (b0) conv_store_q8(da, va, lane);
        if (b1) conv_store_q8(db, vb, lane);
    }
}
__device__ __forceinline__ int conv_base(int l) { return (gridDim.x == 256) ? (l == 0 ? CV_B0 : CV_A1) : 0; }
__device__ __forceinline__ void conv_rounds(const Params& p, int l, int i0, int i1, int wave, int lane) {
    const int nw = gridDim.x * 8, gw = wave * gridDim.x + blockIdx.x;
    if (i1 > i0) conv_strided(p, l, conv_base(l) + i0 * nw, gw, nw, i1 - i0, CONV_T, lane);
}
__device__ __forceinline__ void ph_prologue(const Params& p, int wave, int lane) {
    const int nw = gridDim.x * 8, gw = wave * gridDim.x + blockIdx.x;
    constexpr int T_ADA = 1536, T_MISC = T_ADA + 17, T_DENSE = T_MISC + 1664, T_RW = T_DENSE + 32, T_ALL = T_RW;
    for (int t = gw; t < T_ALL; t += nw) {
        if (t < T_ADA) ada_task(p, t, lane);
        else if (t < T_MISC) misc_task(p, t - T_ADA, lane);
        else if (t < T_DENSE) conv_dense_task(p, t - T_MISC, lane);
        else { const int q = t - T_DENSE, rl = q >> 4, kt = q & 15; bf16_t* lo = (bf16_t*)(p.ws + WS_RW) + (size_t)rl * 64 * 1024;
            conv_tile(p.in[16] + (size_t)rl * 1024 * 64, 64, kt * 64, 0, lo, lo + 32 * 1024, 1024, lane); }
    }
}

__device__ __forceinline__ float row_ss(const f32x4 (&v)[4]) {
    float s = 0.f;
#pragma unroll
    for (int i = 0; i < 4; ++i) s += v[i][0] * v[i][0] + v[i][1] * v[i][1] + v[i][2] * v[i][2] + v[i][3] * v[i][3];
    return wsum(s); }
__device__ __forceinline__ void ph_h0(const Params& p, int wave, int lane) {
    { const unsigned* done = (const unsigned*)(p.ws + ADA_CTR_OFF) + 240; unsigned spins = 0;
      if (lane == 0) { while (__hip_atomic_load(done, __ATOMIC_RELAXED, __HIP_MEMORY_SCOPE_AGENT) < 192u && ++spins < (1u << 22)) __builtin_amdgcn_s_sleep(8); }
      __builtin_amdgcn_fence(__ATOMIC_ACQUIRE, "agent"); }
    const int nw = gridDim.x * 8, gw = blockIdx.x * 8 + wave;
    const float* g = p.in[6];
    const float* mod = (const float*)(p.ws + WS_MOD);
    bf16_t* H = (bf16_t*)(p.ws + WS_BIG + L0_ACT);
    {
        const int r_lo = (int)((long long)gw * TT / nw), r_hi = (int)((long long)(gw + 1) * TT / nw);
        int mr = -1;
        f32x4 gv[4], shv[4], scv[4];
#pragma unroll
        for (int i = 0; i < 4; ++i) { const int c = 4 * lane + 256 * i; gv[i] = ld4(g + c); shv[i] = gv[i]; scv[i] = gv[i]; }
        for (int row = r_lo; row < r_hi; ++row) {
            if (mod_row(row) != mr) { mr = mod_row(row);
#pragma unroll
                for (int i = 0; i < 4; ++i) { const int c = 4 * lane + 256 * i; shv[i] = ld4(mod + mr * 6144 + c); scv[i] = ld4(mod + mr * 6144 + 1024 + c); } }
            const float* src = row < TCTX ? p.in[2] + (size_t)row * DM : p.in[0] + (size_t)(row - TCTX) * DM;
            f32x4 v[4];
#pragma unroll
            for (int i = 0; i < 4; ++i) v[i] = ld4(src + 4 * lane + 256 * i);
            const float rs = rsqrtf(row_ss(v) * (1.0f / DM) + EPS);
#pragma unroll
            for (int i = 0; i < 4; ++i) stbf4(H + (size_t)row * DM + 4 * lane + 256 * i, v[i] * rs * gv[i] * (1.0f + scv[i]) + shv[i]);
        }
    }
}

__device__ __forceinline__ int dma_row(int piece, int lane) { return piece * 16 + (lane >> 2); }
__device__ __forceinline__ int dma_chunk(int lane) { return (lane & 3) ^ ((lane >> 4) & 3); }
template <int NJ>
__device__ __forceinline__ void gemm_issue(LAS uchar* stage, const uchar* const (&ap)[2], const uchar* const (&bp)[NJ / 2], int kbyte, int wave) {
#pragma unroll
    for (int i = 0; i < 2; ++i) dma16(ap[i] + kbyte, stage + (wave * 2 + i) * 1024);
#pragma unroll
    for (int i = 0; i < NJ / 2; ++i) dma16(bp[i] + kbyte, stage + 16384 + (wave * (NJ / 2) + i) * 1024);
}
#define VMWAIT(n) asm volatile("s_waitcnt vmcnt(" #n ")" ::: "memory")
#define VLWAIT(n) asm volatile("s_waitcnt vmcnt(" #n ") lgkmcnt(0)" ::: "memory")
#define BAR_RAW() do { asm volatile("" ::: "memory"); __builtin_amdgcn_s_barrier(); asm volatile("" ::: "memory"); } while (0)
template <int NJ>
__device__ __forceinline__ void gemm_run(LAS uchar* lds, const uchar* const (&ap)[2], const uchar* const (&bp)[NJ / 2], int nkt, f32x16 (&acc)[NJ][2], int wave, int lane) {
    constexpr int STAGE = (256 + NJ * 64) * 64;
    const int r32 = lane & 31, h = lane >> 5, wm = wave >> 1, wn = wave & 1, sw = (r32 >> 2) & 3;
    const int a_base = (wm * 64 + r32) * 64, b_base = 16384 + (wn * NJ * 32 + r32) * 64;
    const int c0 = (h ^ sw) << 4, c1 = ((2 + h) ^ sw) << 4;
    const bool upper = wave >= 4;
    gemm_issue<NJ>(lds, ap, bp, 0, wave);
    gemm_issue<NJ>(lds + STAGE, ap, bp, 64, wave);
    gemm_issue<NJ>(lds + 2 * STAGE, ap, bp, 128, wave);
    if (NJ == 4) VMWAIT(8); else VMWAIT(6);
    if (upper) BAR_RAW();
    for (int kt = 0; kt < nkt; ++kt) {
        BAR_RAW();
        if (kt + 3 < nkt) gemm_issue<NJ>(lds + ((kt + 3) & 3) * STAGE, ap, bp, (kt + 3) * 64, wave);
        const LAS uchar* st = lds + (kt & 3) * STAGE;
        bf16x8 a[2][2], b[2][NJ];
#pragma unroll
        for (int ks = 0; ks < 2; ++ks) {
            const int co = ks ? c1 : c0;
            a[ks][0] = *(const LAS bf16x8*)(st + a_base + co); a[ks][1] = *(const LAS bf16x8*)(st + a_base + 2048 + co);
#pragma unroll
            for (int jn = 0; jn < NJ; ++jn) b[ks][jn] = *(const LAS bf16x8*)(st + b_base + jn * 2048 + co);
        }
        if (kt + 3 < nkt) { if (NJ == 4) VLWAIT(8); else VLWAIT(6); }
        else if (kt + 2 < nkt) { if (NJ == 4) VLWAIT(4); else VLWAIT(3); }
        else VLWAIT(0);
        __builtin_amdgcn_sched_barrier(0);
        BAR_RAW();
        __builtin_amdgcn_sched_barrier(0);
        __builtin_amdgcn_s_setprio(1);
#pragma unroll
        for (int ks = 0; ks < 2; ++ks)
#pragma unroll
            for (int jn = 0; jn < NJ; ++jn) { acc[jn][0] = MFMA32(b[ks][jn], a[ks][0], acc[jn][0]); acc[jn][1] = MFMA32(b[ks][jn], a[ks][1], acc[jn][1]); }
        __builtin_amdgcn_s_setprio(0);
        __builtin_amdgcn_sched_barrier(0);
    }
    if (!upper) BAR_RAW();
}
__device__ __forceinline__ int dma64_row(int piece, int lane) { return piece * 8 + (lane >> 3); }
__device__ __forceinline__ int dma64_chunk(int piece, int lane) { return (lane & 7) ^ ((piece * 4 + (lane >> 4)) & 7); }
template <int NJ>
__device__ __forceinline__ void dense64_ptrs(const bf16_t* A, const bf16_t* Bt, int K, int m0, int n0, const uchar* (&ap)[4], const uchar* (&bp)[NJ], int wave, int lane) {
#pragma unroll
    for (int i = 0; i < 4; ++i) { const int pc = wave * 4 + i; ap[i] = (const uchar*)(A + (size_t)(m0 + dma64_row(pc, lane)) * K) + dma64_chunk(pc, lane) * 16; }
#pragma unroll
    for (int i = 0; i < NJ; ++i) { const int pc = wave * NJ + i; bp[i] = (const uchar*)(Bt + (size_t)(n0 + dma64_row(pc, lane)) * K) + dma64_chunk(pc, lane) * 16; }
}
template <int NJ, bool DB = true>
__device__ __forceinline__ void gemm64_run(LAS uchar* lds, const uchar* const (&ap)[4], const uchar* const (&bp)[NJ], int nkt, f32x16 (&acc)[NJ][2], int wave, int lane) {
    constexpr int STAGE = (256 + NJ * 64) * 128;
    const int r32 = lane & 31, h = lane >> 5, wm = wave >> 1, wn = wave & 1;
    const int a_base = (wm * 64 + r32) * 128, b_base = 32768 + (wn * NJ * 32 + r32) * 128, cx = (h ^ ((r32 >> 1) & 7)) << 4;
#pragma unroll
    for (int i = 0; i < 4; ++i) dma16(ap[i], lds + (wave * 4 + i) * 1024);
#pragma unroll
    for (int i = 0; i < NJ; ++i) dma16(bp[i], lds + 32768 + (wave * NJ + i) * 1024);
    for (int kt = 0; kt < nkt; ++kt) {
        VMWAIT(0);
        BAR_RAW();
        const LAS uchar* st = lds + (kt & 1) * STAGE;
        LAS uchar* sn = lds + ((kt + 1) & 1) * STAGE;
        const int kb = (kt + 1) * 128;
        const bool more = kt + 1 < nkt;
        bf16x8 fa[2][2], fb[2][NJ];
#define LDFRAG(set_, ks_) do { const int co_ = cx ^ ((ks_) << 5); \
            fa[set_][0] = *(const LAS bf16x8*)(st + a_base + co_); fa[set_][1] = *(const LAS bf16x8*)(st + a_base + 4096 + co_); \
            _Pragma("unroll") for (int jn = 0; jn < NJ; ++jn) fb[set_][jn] = *(const LAS bf16x8*)(st + b_base + jn * 4096 + co_); } while (0)
        LDFRAG(0, 0);
#pragma unroll
        for (int ks = 0; ks < 4; ++ks) {
            if (more) {
                if (ks < 2) { dma16(ap[2 * ks] + kb, sn + (wave * 4 + 2 * ks) * 1024); dma16(ap[2 * ks + 1] + kb, sn + (wave * 4 + 2 * ks + 1) * 1024); }
                else {
#pragma unroll
                    for (int i = (ks - 2) * (NJ / 2); i < (ks - 1) * (NJ / 2); ++i) dma16(bp[i] + kb, sn + 32768 + (wave * NJ + i) * 1024);
                }
            }
            if (DB) { if (ks < 3) LDFRAG((ks + 1) & 1, ks + 1); } else { if (ks > 0) LDFRAG(ks & 1, ks); }
            __builtin_amdgcn_sched_barrier(0);
            __builtin_amdgcn_s_setprio(1);
#pragma unroll
            for (int jn = 0; jn < NJ; ++jn) { acc[jn][0] = MFMA32(fb[ks & 1][jn], fa[ks & 1][0], acc[jn][0]); acc[jn][1] = MFMA32(fb[ks & 1][jn], fa[ks & 1][1], acc[jn][1]); }
            __builtin_amdgcn_s_setprio(0);
            __builtin_amdgcn_sched_barrier(0);
        }
#undef LDFRAG
    }
}
template <int NJ> __device__ __forceinline__ void zero_acc(f32x16 (&acc)[NJ][2]) {
#pragma unroll
    for (int a = 0; a < NJ; ++a)
#pragma unroll
        for (int b = 0; b < 2; ++b)
#pragma unroll
            for (int r = 0; r < 16; ++r) acc[a][b][r] = 0.f;
}
template <int NJ>
__device__ __forceinline__ void dense_ptrs(const bf16_t* A, const bf16_t* Bt, int K, int m0, int n0, const uchar* (&ap)[2], const uchar* (&bp)[NJ / 2], int wave, int lane) {
#pragma unroll
    for (int i = 0; i < 2; ++i) ap[i] = (const uchar*)(A + (size_t)(m0 + dma_row(wave * 2 + i, lane)) * K) + dma_chunk(lane) * 16;
#pragma unroll
    for (int i = 0; i < NJ / 2; ++i) bp[i] = (const uchar*)(Bt + (size_t)(n0 + dma_row(wave * (NJ / 2) + i, lane)) * K) + dma_chunk(lane) * 16;
}
__device__ __forceinline__ void tok_pos(int row, int& b, int& pos) {
    if (row < TCTX) { b = row >> 8; pos = row & 255; } else { b = (row - TCTX) >> 12; pos = LCTX + ((row - TCTX) & 4095); } }
__device__ __forceinline__ void rope_head(f32x16 (&v)[2], int row, int h, const float* ct, const float* st) {
    const int t = (row - TCTX) & 4095;
#pragma unroll
    for (int jn = 0; jn < 2; ++jn) {
        const int pc = (jn == 0) ? (t >> 6) : (t & 63);
#pragma unroll
        for (int rq = 0; rq < 4; ++rq) {
            const f32x2 c = *(const f32x2*)(ct + pc * 16 + 4 * rq + 2 * h), s = *(const f32x2*)(st + pc * 16 + 4 * rq + 2 * h);
            const float x1 = v[jn][4 * rq], x2 = v[jn][4 * rq + 1], y1 = v[jn][4 * rq + 2], y2 = v[jn][4 * rq + 3];
            v[jn][4 * rq] = x1 * c.x - x2 * s.x; v[jn][4 * rq + 1] = x1 * s.x + x2 * c.x;
            v[jn][4 * rq + 2] = y1 * c.y - y2 * s.y; v[jn][4 * rq + 3] = y1 * s.y + y2 * c.y;
        }
    }
}
__device__ __forceinline__ void store_blk32(bf16_t* dst, const f32x16& v, int h) {
#pragma unroll
    for (int pr = 0; pr < 2; ++pr) {
        const unsigned ax = cvt_pk(v[8 * pr], v[8 * pr + 1]), ay = cvt_pk(v[8 * pr + 2], v[8 * pr + 3]);
        const unsigned bx = cvt_pk(v[8 * pr + 4], v[8 * pr + 5]), by = cvt_pk(v[8 * pr + 6], v[8 * pr + 7]);
        const auto rx = __builtin_amdgcn_permlane32_swap(ax, bx, false, false);
        const auto ry = __builtin_amdgcn_permlane32_swap(ay, by, false, false);
        u32x4 w; w.x = rx[0]; w.y = ry[0]; w.z = rx[1]; w.w = ry[1];
        *(u32x4*)(dst + 16 * pr + 8 * h) = w;
    }
}
__device__ __forceinline__ void store_head8(uchar* dst, const f32x16 (&v)[2], int h, float qs) {
#pragma unroll
    for (int jn = 0; jn < 2; ++jn) {
        unsigned q4[4];
#pragma unroll
        for (int rq = 0; rq < 4; ++rq) q4[rq] = pk_fp8x4(v[jn][4 * rq] * qs, v[jn][4 * rq + 1] * qs, v[jn][4 * rq + 2] * qs, v[jn][4 * rq + 3] * qs);
        const auto ra = __builtin_amdgcn_permlane32_swap(q4[0], q4[2], false, false);
        const auto rb = __builtin_amdgcn_permlane32_swap(q4[1], q4[3], false, false);
        u32x4 q; q.x = ra[0]; q.y = ra[1]; q.z = rb[0]; q.w = rb[1];
        *(u32x4*)(dst + jn * 32 + 16 * h) = q;
    }
}
__device__ __forceinline__ void vt_scatter(LAS uchar* lt, const f32x16 (&v)[2], int im, int r32, int h) {
    const int j = 32 * ((r32 >> 2) & 1) + 16 * im + (r32 & 3) + 4 * (r32 >> 3);
    LAS uchar* base = lt + (4 * h) * 64 + j;
#pragma unroll
    for (int jn = 0; jn < 2; ++jn)
#pragma unroll
        for (int rq = 0; rq < 4; ++rq) {
            const unsigned w = pk_fp8x4(v[jn][4 * rq] * V_QS, v[jn][4 * rq + 1] * V_QS, v[jn][4 * rq + 2] * V_QS, v[jn][4 * rq + 3] * V_QS);
#pragma unroll
            for (int i = 0; i < 4; ++i) base[(jn * 32 + i + 8 * rq) * 64] = (uchar)(w >> (8 * i));
        }
}
__device__ __forceinline__ void store_head(bf16_t* dst, const f32x16 (&v)[2], int h) {
    store_blk32(dst, v[0], h); store_blk32(dst + 32, v[1], h);
}

#define DENSE_UNITS(mt_, nt_, mt_lo_, nM_, nN_) \
    for (int q_ = (int)blockIdx.x >> 3, mt_ = (mt_lo_) + ((int)blockIdx.x & 7) + 8 * (q_ / (nN_)), nt_ = q_ % (nN_); mt_ < (nM_); \
         q_ += (int)gridDim.x >> 3, mt_ = (mt_lo_) + ((int)blockIdx.x & 7) + 8 * (q_ / (nN_)), nt_ = q_ % (nN_))
__device__ __forceinline__ void ph_inproj0(const Params& p, LAS uchar* lds, int wave, int lane) {
    const bf16_t* A = (const bf16_t*)(p.ws + WS_BIG + L0_ACT);
    const bf16_t* Bt = (const bf16_t*)(p.ws + WS_WD + WD_ABIN);
    const float* ct = (const float*)(p.ws + WS_ROPE); const float* st = ct + 1024;
    uchar* big = p.ws + WS_BIG;
    const int r32 = lane & 31, h = lane >> 5, wm = wave >> 1, wn = wave & 1;
    DENSE_UNITS(mt, nt, 0, 68, 6) {
        const uchar* ap[4]; const uchar* bp[4];
        dense64_ptrs<4>(A, Bt, 1024, mt * 256, nt * 256, ap, bp, wave, lane);
        f32x16 acc[4][2]; zero_acc<4>(acc);
        gemm64_run<4, false>(lds, ap, bp, 16, acc, wave, lane);
#pragma unroll
        for (int hh = 0; hh < 2; ++hh) {
            const int hs = nt * 4 + wn * 2 + hh;
            const bool is_norm = hs < 10, is_rope = (hs < 10) || (hs >= 12 && hs < 22), is_q = (hs < 8) || (hs >= 12 && hs < 20);
            f32x16 gn[2];
            if (is_norm) { const float* g = p.in[hs < 8 ? 9 : 10];
#pragma unroll
                for (int jn = 0; jn < 2; ++jn)
#pragma unroll
                    for (int rq = 0; rq < 4; ++rq) { const f32x4 t = ld4(g + jn * 32 + 8 * rq + 4 * h); gn[jn][4 * rq] = t[0]; gn[jn][4 * rq + 1] = t[1]; gn[jn][4 * rq + 2] = t[2]; gn[jn][4 * rq + 3] = t[3]; } }
#pragma unroll
            for (int im = 0; im < 2; ++im) {
                const int row = mt * 256 + wm * 64 + im * 32 + r32;
                f32x16 v[2] = {acc[2 * hh][im], acc[2 * hh + 1][im]};
                if (is_norm) {
                    float ss = 0.f;
#pragma unroll
                    for (int r = 0; r < 16; ++r) ss += v[0][r] * v[0][r] + v[1][r] * v[1][r];
                    ss += __shfl_xor(ss, 32);
                    const float rs = rsqrtf(ss * (1.0f / 64.0f) + EPS);
#pragma unroll
                    for (int r = 0; r < 16; ++r) { v[0][r] = v[0][r] * rs * gn[0][r]; v[1][r] = v[1][r] * rs * gn[1][r]; }
                }
                if (is_rope && row >= TCTX) rope_head(v, row, h, ct, st);
                if (is_q) {
#pragma unroll
                    for (int r = 0; r < 16; ++r) { v[0][r] *= QSCALE; v[1][r] *= QSCALE; } }
                int b, pos; tok_pos(row, b, pos);
                if (hs < 8) store_head8(big + L0_QA + (size_t)row * 512 + hs * 64, v, h, Q_QS);
                else if (hs < 10) store_head8(big + L0_KA + ((size_t)(b * 2 + hs - 8) * NPOS + pos) * 64, v, h, K_QS);
                else if (hs < 12) vt_scatter(lds + hh * 16384 + wm * 4096, v, im, r32, h);
                else if (hs < 20) store_head8(big + L0_QB + (size_t)row * 512 + (hs - 12) * 64, v, h, Q_QS);
                else if (hs < 22) store_head8(big + L0_KB + ((size_t)(b * 2 + hs - 20) * NPOS + pos) * 64, v, h, K_QS);
                else vt_scatter(lds + hh * 16384 + wm * 4096, v, im, r32, h);
            }
        }
        if (nt == 2 || nt == 5) {
            asm volatile("s_waitcnt lgkmcnt(0)" ::: "memory"); BAR_RAW();
            int b0, pos0; tok_pos(mt * 256, b0, pos0);
            uchar* vt = big + (nt == 2 ? L0_VA : L0_VB);
#pragma unroll
            for (int i = 0; i < 4; ++i) { const int ca = (int)threadIdx.x + 512 * i, sidx = ca >> 10, c = ca & 1023;
                const u32x4 w = *(const LAS u32x4*)(lds + sidx * 16384 + c * 16);
                *(u32x4*)(vt + (size_t)(b0 * 2 + sidx) * NPOS * 64 + (size_t)(pos0 >> 6) * 4096 + c * 16) = w; }
            __syncthreads();
        }
    }
    if (gridDim.x == 256) {
        const int x = blockIdx.x & 7, r = blockIdx.x >> 3; int ib = -1;
        if (x < 4) { if (r >= 22) ib = x * 10 + (r - 22); } else { if (r >= 16) ib = 40 + (x - 4) * 16 + (r - 16); }
        if (ib >= 0) conv_strided(p, 0, 0, ib * 8 + wave, 832, 4, CV_A0, lane);
    }
}
template <int NJ>
__device__ __forceinline__ void inproj1_unit(const Params& p, LAS uchar* lds, int wave, int lane, int mt, int nt) {
    constexpr int SL = NJ / 2;
    const bf16_t* A = (const bf16_t*)(p.ws + WS_BIG + L1_H);
    const bf16_t* Bt = (const bf16_t*)(p.ws + WS_WD + WD_CIN);
    const float* ct = (const float*)(p.ws + WS_ROPE); const float* st = ct + 1024;
    uchar* big = p.ws + WS_BIG;
    const int r32 = lane & 31, h = lane >> 5, wm = wave >> 1, wn = wave & 1;
    const uchar* ap[4]; const uchar* bp[NJ];
    dense64_ptrs<NJ>(A, Bt, 1024, mt * 256, nt * NJ * 64, ap, bp, wave, lane);
    f32x16 acc[NJ][2]; zero_acc<NJ>(acc);
    gemm64_run<NJ>(lds, ap, bp, 16, acc, wave, lane);
#pragma unroll
    for (int hh = 0; hh < SL; ++hh) {
        const int hs = nt * NJ + wn * SL + hh;
#pragma unroll
        for (int im = 0; im < 2; ++im) {
            const int row = mt * 256 + wm * 64 + im * 32 + r32;
            f32x16 v[2] = {acc[2 * hh][im], acc[2 * hh + 1][im]};
            if (hs < 32 && row >= TCTX) rope_head(v, row, h, ct, st);
            if (hs < 16) {
#pragma unroll
                for (int r = 0; r < 16; ++r) { v[0][r] *= QSCALE; v[1][r] *= QSCALE; } }
            int b, pos; tok_pos(row, b, pos);
            if (hs < 16) store_head8(big + L1_QC + (size_t)row * 1024 + hs * 64, v, h, Q_QS);
            else if (hs < 32) store_head8(big + L1_KC + ((size_t)(b * 16 + hs - 16) * NPOS + pos) * 64, v, h, K_QS);
            else vt_scatter(lds + (wn * SL + hh) * 16384 + wm * 4096, v, im, r32, h);
        }
    }
    if (nt * NJ >= 32) {
        asm volatile("s_waitcnt lgkmcnt(0)" ::: "memory"); BAR_RAW();
        int b0, pos0; tok_pos(mt * 256, b0, pos0);
#pragma unroll
        for (int i = 0; i < 2 * NJ; ++i) { const int ca = (int)threadIdx.x + 512 * i, sidx = ca >> 10, c = ca & 1023;
            const int hv = nt * NJ + sidx - 32, head = hv >> 1, half = hv & 1;
            const u32x4 w = *(const LAS u32x4*)(lds + sidx * 16384 + c * 16);
            *(u32x4*)(big + L1_VC + (size_t)(b0 * 8 + head) * NPOS * 128 + (size_t)((pos0 >> 6) + (c >> 8)) * 8192 + half * 4096 + (c & 255) * 16) = w; }
        __syncthreads();
    }
}
__device__ __forceinline__ void ph_inproj1(const Params& p, LAS uchar* lds, int wave, int lane) {
    DENSE_UNITS(mt, nt, 0, 64, 12) inproj1_unit<4>(p, lds, wave, lane, mt, nt);
    for (int u = blockIdx.x; u < 96; u += gridDim.x) inproj1_unit<2>(p, lds, wave, lane, 64 + (u & 3), u >> 2);
    if (gridDim.x == 256 && blockIdx.x >= 96) conv_strided(p, 1, 0, ((int)blockIdx.x - 96) * 8 + wave, 1280, 2, CV_A1, lane);
}
template <int NJ>
__device__ __forceinline__ void ph_outproj(const Params& p, LAS uchar* lds, int wave, int lane, const bf16_t* A, const bf16_t* Bt, bf16_t* PO, int mt_lo) {
    constexpr int NTN = 1024 / (NJ * 64);
    const int r32 = lane & 31, h = lane >> 5, wm = wave >> 1, wn = wave & 1;
    DENSE_UNITS(mt, nt, mt_lo, 68, NTN) {
        const uchar* ap[4]; const uchar* bp[NJ];
        dense64_ptrs<NJ>(A, Bt, 1024, mt * 256, nt * NJ * 64, ap, bp, wave, lane);
        f32x16 acc[NJ][2]; zero_acc<NJ>(acc);
        gemm64_run<NJ>(lds, ap, bp, 16, acc, wave, lane);
#pragma unroll
        for (int im = 0; im < 2; ++im) {
            const int row = mt * 256 + wm * 64 + im * 32 + r32;
#pragma unroll
            for (int jn = 0; jn < NJ; ++jn) store_blk32(PO + (size_t)row * 1024 + nt * NJ * 64 + wn * NJ * 32 + jn * 32, acc[jn][im], h);
        }
    }
    if (NJ == 2 && mt_lo == 0 && gridDim.x == 256) {
        const int x = blockIdx.x & 7, r = blockIdx.x >> 3; int jb = -1;
        if (x < 4) { if (r >= 8) jb = x * 24 + (r - 8); } else jb = 96 + (x - 4) * 32 + r;
        if (jb >= 0) conv_strided(p, 0, CV_A0, jb * 8 + wave, 1792, 1, CV_B0, lane);
    }
}

template <int DV> __device__ __forceinline__ void attn_issue(LAS uchar* st, const uchar* k0p, const uchar* k1p, const uchar* vp0, const uchar* vp1, int tpos, bool two_k, int wave) {
    if (wave < 4) dma16(k0p + (size_t)tpos * 4096, st + wave * 1024);
    else if (two_k) dma16(k1p + (size_t)tpos * 4096, st + 4096 + (wave - 4) * 1024);
    if (DV == 64) { if (wave >= 4) dma16(vp0 + (size_t)tpos * 4096, st + 8192 + (wave - 4) * 1024); }
    else dma16(vp0 + (size_t)tpos * 8192, st + 8192 + wave * 1024);
}
struct AttnUnit {
    const uchar *q0, *q1;
    int qstride;
    const uchar *k0, *k1;
    const uchar* v;
    int t0b, t0e, t1b, t1e;
    int qlat0;
    float sink0, sink1;
    bf16_t *o0, *o1;
    int ostride;
};
template <int DV, int MODE, int AF = 0>
__device__ __forceinline__ void attn_unit(const Params& p, LAS uchar* lds, const AttnUnit& U, int wave, int lane) {
    constexpr int DVB = DV / 32;
    const int r32 = lane & 31, h = lane >> 5, s = wave >> 2, qs = wave & 3;
    const int krow = (wave & 3) * 16 + (lane >> 2);
    const uchar* k0p = U.k0 + krow * 64 + dma_chunk(lane) * 16;
    const uchar* k1p = U.k1 + krow * 64 + dma_chunk(lane) * 16;
    const uchar* vp0 = U.v + (((DV == 64) ? (wave & 3) : wave) * 16 + (lane >> 2)) * 64 + dma_chunk(lane) * 16;
    const uchar* vp1 = vp0;
    const int n0 = U.t0e - U.t0b, nt = n0 + (U.t1e - U.t1b);
    i32x8 qf;
    { const uchar* qp = (s ? U.q1 : U.q0) + (size_t)(qs * 32 + r32) * U.qstride + 32 * h;
      const i32x4 lo_ = *(const i32x4*)qp, hi_ = *(const i32x4*)(qp + 16);
      qf = __builtin_shufflevector(lo_, hi_, 0, 1, 2, 3, 4, 5, 6, 7); }
    f32x16 O[DVB];
#pragma unroll
    for (int d = 0; d < DVB; ++d)
#pragma unroll
        for (int r = 0; r < 16; ++r) O[d][r] = 0.f;
    float m = -1e30f, l = 0.f;
    const int qlat = U.qlat0 + qs * 32 + r32, qw0 = U.qlat0 + qs * 32;
    const int kbase = r32 * 64, kc0 = ((2 * h) ^ ((r32 >> 2) & 3)) << 4, kc1 = ((2 * h + 1) ^ ((r32 >> 2) & 3)) << 4;
#define TILE_POS(jj) (((jj) < n0) ? U.t0b + (jj) : U.t1b + ((jj) - n0))
#define PV_TILE(stp) do { const LAS uchar* Vl_ = (stp) + 8192 + kbase; \
        _Pragma("unroll") for (int d = 0; d < DVB; ++d) { \
            const i32x4 a_ = *(const LAS i32x4*)(Vl_ + d * 2048 + kc0), b_ = *(const LAS i32x4*)(Vl_ + d * 2048 + kc1); \
            const i32x8 vf = __builtin_shufflevector(a_, b_, 0, 1, 2, 3, 4, 5, 6, 7); \
            O[d] = __builtin_amdgcn_mfma_scale_f32_32x32x64_f8f6f4(vf, pq, O[d], 0, 0, 0, V_E8M0, 0, P_E8M0); } } while (0)
    attn_issue<DV>(lds, k0p, k1p, vp0, vp1, TILE_POS(0), MODE == 2, wave);
    if (nt > 1) attn_issue<DV>(lds + 32768, k0p, k1p, vp0, vp1, TILE_POS(1), MODE == 2, wave);
    asm volatile("" :: "v"(qf));
    f32x16 cinit;
#pragma unroll
    for (int r = 0; r < 16; ++r) cinit[r] = P_OFF;
    asm volatile("" : "+v"(cinit));
    i32x8 pq; bool have = false; const LAS uchar* pst = lds;
    for (int j = 0; j < nt; ++j) {
        if (!(AF & 8)) { if (j + 1 < nt) { if (MODE == 2) VMWAIT(2); else VMWAIT(1); } else VMWAIT(0);
        BAR_RAW(); }
        const LAS uchar* st = lds + (j & 3) * 32768;
        if (j + 2 < nt && !(AF & 8)) attn_issue<DV>(lds + ((j + 2) & 3) * 32768, k0p, k1p, vp0, vp1, TILE_POS(j + 2), MODE == 2, wave);
        const int tp = TILE_POS(j);
        const int kl0 = tp * 64 - LCTX;
        bool skip = false;
        if (MODE == 1 && kl0 >= 0) skip = (kl0 > qw0 + 31 + 128) || (kl0 + 63 < qw0 - 128);
        f32x16 S0, S1;
        if (!skip) {
            const LAS uchar* Kl = st + ((MODE == 2) ? s * 4096 : 0);
            if (!(AF & 4)) {
            { i32x8 kf0, kf1;
              { const i32x4 a_ = *(const LAS i32x4*)(Kl + kbase + kc0), b_ = *(const LAS i32x4*)(Kl + kbase + kc1); kf0 = __builtin_shufflevector(a_, b_, 0, 1, 2, 3, 4, 5, 6, 7); }
              { const i32x4 a_ = *(const LAS i32x4*)(Kl + kbase + 2048 + kc0), b_ = *(const LAS i32x4*)(Kl + kbase + 2048 + kc1); kf1 = __builtin_shufflevector(a_, b_, 0, 1, 2, 3, 4, 5, 6, 7); }
              S0 = __builtin_amdgcn_mfma_scale_f32_32x32x64_f8f6f4(kf0, qf, cinit, 0, 0, 0, K_E8M0, 0, Q_E8M0);
              S1 = __builtin_amdgcn_mfma_scale_f32_32x32x64_f8f6f4(kf1, qf, cinit, 0, 0, 0, K_E8M0, 0, Q_E8M0); }
            } else { asm volatile("" : "+v"(S0), "+v"(S1)); }
        }
        if (have && !(AF & 2)) PV_TILE(pst);
        if (!skip) {
            if (MODE == 1 && kl0 >= 0) {
#pragma unroll
                for (int r = 0; r < 16; ++r) {
                    const int d0 = qlat - (kl0 + crow(r, h)), d1 = d0 - 32;
                    if (d0 > 128 || d0 < -128) S0[r] = -1e30f;
                    if (d1 > 128 || d1 < -128) S1[r] = -1e30f;
                }
            }
            if (j == 0) {
                float mx = fmaxf(S0[0], S1[0]);
#pragma unroll
                for (int r = 1; r < 16; ++r) mx = fmaxf(mx, fmaxf(S0[r], S1[r]));
                { const auto rr_ = __builtin_amdgcn_permlane32_swap(__float_as_uint(mx), __float_as_uint(mx), false, false); mx = fmaxf(__uint_as_float(rr_[0]), __uint_as_float(rr_[1])); }
                m = mx - P_OFF;
                float ls = 0.f;
#pragma unroll
                for (int r = 0; r < 16; ++r) { S0[r] = __builtin_amdgcn_exp2f(S0[r] - m); S1[r] = __builtin_amdgcn_exp2f(S1[r] - m); ls += S0[r] + S1[r]; }
                l = ls;
#pragma unroll
                for (int r = 0; r < 16; ++r) cinit[r] = P_OFF - m;
                asm volatile("" : "+v"(cinit));
            } else {
                float tm;
                asm volatile("s_nop 15\n\tv_max3_f32 %0, %1, %2, %3" : "=v"(tm) : "v"(S0[0]), "v"(S1[0]), "v"(S0[1]));
#pragma unroll
                for (int r = 1; r < 15; ++r) asm("v_max3_f32 %0, %1, %2, %3" : "=v"(tm) : "v"(tm), "v"(S1[r]), "v"(S0[r + 1]));
                asm("v_max_f32 %0, %1, %2" : "=v"(tm) : "v"(tm), "v"(S1[15]));
                { const auto rr_ = __builtin_amdgcn_permlane32_swap(__float_as_uint(tm), __float_as_uint(tm), false, false); tm = fmaxf(__uint_as_float(rr_[0]), __uint_as_float(rr_[1])); }
                if (__any(tm > ATT_THR + P_OFF)) {
                    const float dlt = tm > ATT_THR + P_OFF ? tm - P_OFF : 0.f, alpha = __builtin_amdgcn_exp2f(-dlt);
                    m += dlt; l *= alpha;
#pragma unroll
                    for (int r = 0; r < 16; ++r) { S0[r] -= dlt; S1[r] -= dlt; cinit[r] = P_OFF - m; }
                    asm volatile("" : "+v"(cinit));
#pragma unroll
                    for (int d = 0; d < DVB; ++d)
#pragma unroll
                        for (int r = 0; r < 16; ++r) O[d][r] *= alpha;
                }
                float ls = 0.f;
#pragma unroll
                for (int r = 0; r < 16; ++r) { S0[r] = __builtin_amdgcn_exp2f(S0[r]); S1[r] = __builtin_amdgcn_exp2f(S1[r]); ls += S0[r] + S1[r]; }
                l += ls;
            }
            pq[0] = (int)pk_fp8x4_nc(S0[0], S0[1], S0[2], S0[3]);       pq[1] = (int)pk_fp8x4_nc(S0[4], S0[5], S0[6], S0[7]);
            pq[2] = (int)pk_fp8x4_nc(S0[8], S0[9], S0[10], S0[11]);     pq[3] = (int)pk_fp8x4_nc(S0[12], S0[13], S0[14], S0[15]);
            pq[4] = (int)pk_fp8x4_nc(S1[0], S1[1], S1[2], S1[3]);       pq[5] = (int)pk_fp8x4_nc(S1[4], S1[5], S1[6], S1[7]);
            pq[6] = (int)pk_fp8x4_nc(S1[8], S1[9], S1[10], S1[11]);     pq[7] = (int)pk_fp8x4_nc(S1[12], S1[13], S1[14], S1[15]);
            have = true; pst = st;
        } else have = false;
    }
    if (have && !(AF & 2)) PV_TILE(pst);
#undef PV_TILE
    float lt = l + __shfl_xor(l, 32);
    if (MODE == 1) lt += __builtin_amdgcn_exp2f((s ? U.sink1 : U.sink0) - m + P_OFF);
    const float inv = P_QS / lt;
#pragma unroll
    for (int d = 0; d < DVB; ++d)
#pragma unroll
        for (int r = 0; r < 16; ++r) O[d][r] *= inv;
    if (MODE != 2) {
        bf16_t* op = (s ? U.o1 : U.o0) + (size_t)(qs * 32 + r32) * U.ostride;
#pragma unroll
        for (int d = 0; d < DVB; ++d)
#pragma unroll
            for (int rq = 0; rq < 4; ++rq) stbf4(op + d * 32 + 8 * rq + 4 * h, (f32x4){O[d][4 * rq], O[d][4 * rq + 1], O[d][4 * rq + 2], O[d][4 * rq + 3]});
        __syncthreads();
    } else {
        __syncthreads();
        LAS float* X = (LAS float*)lds + (size_t)qs * DVB * 16 * 64 + lane;
        if (s == 1) {
#pragma unroll
            for (int d = 0; d < DVB; ++d)
#pragma unroll
                for (int r = 0; r < 16; ++r) X[(d * 16 + r) * 64] = O[d][r];
        }
        __syncthreads();
        if (s == 0) {
            const float lam = *(const float*)(p.ws + WS_LAM);
            float ss = 0.f;
#pragma unroll
            for (int d = 0; d < DVB; ++d)
#pragma unroll
                for (int r = 0; r < 16; ++r) { const float o = O[d][r] - lam * X[(d * 16 + r) * 64]; O[d][r] = o; ss += o * o; }
            ss += __shfl_xor(ss, 32);
            const float rs = rsqrtf(ss * (1.0f / 128.0f) + EPS) * (1.0f - LAMBDA_INIT);
            const float* sg = p.in[15];
            bf16_t* op = U.o0 + (size_t)(qs * 32 + r32) * U.ostride;
#pragma unroll
            for (int d = 0; d < DVB; ++d)
#pragma unroll
                for (int rq = 0; rq < 4; ++rq) { const f32x4 g = ld4(sg + d * 32 + 8 * rq + 4 * h);
                    stbf4(op + d * 32 + 8 * rq + 4 * h, (f32x4){O[d][4 * rq] * rs * g[0], O[d][4 * rq + 1] * rs * g[1], O[d][4 * rq + 2] * rs * g[2], O[d][4 * rq + 3] * rs * g[3]}); }
        }
        __syncthreads();
    }
}
__device__ __forceinline__ void ph_attn0(const Params& p, LAS uchar* lds, int wave, int lane) {
    uchar* big = p.ws + WS_BIG;
    const uchar *QA = big + L0_QA, *QB = big + L0_QB, *KA = big + L0_KA, *KB = big + L0_KB, *VA = big + L0_VA, *VB = big + L0_VB;
    bf16_t* Oo = (bf16_t*)(big + L0_ACT);
    const float* sink = p.in[11];
    int cdone = 0; const int crounds = (CONV_T - conv_base(0) + (int)gridDim.x * 8 - 1) / ((int)gridDim.x * 8);
    for (int u = blockIdx.x; u < 512; u += gridDim.x) {
        const int xq = u & 7, iq = u >> 3, b = xq >> 1, kvh = xq & 1, pr = iq >> 5, qt = iq & 31, hd = kvh * 4 + pr * 2;
        const size_t row0 = (size_t)TCTX + (size_t)b * SEQ + qt * 128;
        AttnUnit U; U.qstride = 512; U.ostride = 1024;
        U.q0 = QA + row0 * 512 + hd * 64; U.q1 = U.q0 + 64;
        U.k0 = U.k1 = KA + (size_t)(b * 2 + kvh) * NPOS * 64; U.v = VA + (size_t)(b * 2 + kvh) * NPOS * 64;
        U.t0b = 0; U.t0e = NPOS / 64; U.t1b = 0; U.t1e = 0; U.qlat0 = qt * 128; U.sink0 = U.sink1 = 0.f;
        U.o0 = Oo + row0 * 1024 + hd * 64; U.o1 = U.o0 + 64;
        attn_unit<64, 0>(p, lds, U, wave, lane);
        conv_rounds(p, 0, cdone, cdone + 4, wave, lane); cdone += 4;
    }
    for (int u = blockIdx.x; u < 512; u += gridDim.x) {
        const int xq = u & 7, iq = u >> 3, b = xq >> 1, kvh = xq & 1, pr = iq >> 5, qt = iq & 31, hd = kvh * 4 + pr * 2;
        const size_t row0 = (size_t)TCTX + (size_t)b * SEQ + qt * 128;
        AttnUnit U; U.qstride = 512; U.ostride = 1024;
        U.q0 = QB + row0 * 512 + hd * 64; U.q1 = U.q0 + 64;
        U.k0 = U.k1 = KB + (size_t)(b * 2 + kvh) * NPOS * 64; U.v = VB + (size_t)(b * 2 + kvh) * NPOS * 64;
        const int lo = qt * 128 - 128 < 0 ? 0 : qt * 128 - 128, hi = qt * 128 + 256 > SEQ ? SEQ : qt * 128 + 256;
        U.t0b = 0; U.t0e = 4; U.t1b = 4 + lo / 64; U.t1e = 4 + hi / 64; U.qlat0 = qt * 128;
        U.sink0 = sink[hd] * LOG2E; U.sink1 = sink[hd + 1] * LOG2E;
        U.o0 = Oo + row0 * 1024 + 512 + hd * 64; U.o1 = U.o0 + 64;
        attn_unit<64, 1>(p, lds, U, wave, lane);
    }
    for (int u = blockIdx.x; u < 64; u += gridDim.x) {
        const int ty = u >> 5, b = (u >> 3) & 3, kvh = (u >> 2) & 1, pr = (u >> 1) & 1, qt = u & 1, hd = kvh * 4 + pr * 2;
        const size_t row0 = (size_t)b * LCTX + qt * 128;
        AttnUnit U; U.qstride = 512; U.ostride = 1024;
        U.q0 = (ty ? QB : QA) + row0 * 512 + hd * 64; U.q1 = U.q0 + 64;
        U.k0 = U.k1 = (ty ? KB : KA) + (size_t)(b * 2 + kvh) * NPOS * 64; U.v = (ty ? VB : VA) + (size_t)(b * 2 + kvh) * NPOS * 64;
        U.t0b = 0; U.t0e = 4; U.t1b = 0; U.t1e = 0; U.qlat0 = -100000;
        U.sink0 = sink[hd] * LOG2E; U.sink1 = sink[hd + 1] * LOG2E;
        U.o0 = Oo + row0 * 1024 + ty * 512 + hd * 64; U.o1 = U.o0 + 64;
        if (ty) attn_unit<64, 1>(p, lds, U, wave, lane); else attn_unit<64, 0>(p, lds, U, wave, lane);
    }
    conv_rounds(p, 0, cdone, crounds, wave, lane);
}
template <int AF>
__device__ __forceinline__ void ph_attn1(const Params& p, LAS uchar* lds, int wave, int lane) {
    uchar* big = p.ws + WS_BIG;
    const uchar *QC = big + L1_QC, *KC = big + L1_KC, *VC = big + L1_VC;
    bf16_t* Oo = (bf16_t*)(big + (AF ? L1_PO : L1_O));
    int cdone = 0; const int crounds = (CONV_T - conv_base(1) + (int)gridDim.x * 8 - 1) / ((int)gridDim.x * 8);
    for (int u = blockIdx.x; u < 1024; u += gridDim.x) {
        const int b = u >> 8, hd = u & 7, qt = (u >> 3) & 31;
        const size_t row0 = (size_t)TCTX + (size_t)b * SEQ + qt * 128;
        AttnUnit U; U.qstride = 1024; U.ostride = 1024;
        U.q0 = QC + row0 * 1024 + hd * 128; U.q1 = U.q0 + 64;
        U.k0 = KC + (size_t)(b * 16 + hd * 2) * NPOS * 64; U.k1 = U.k0 + (size_t)NPOS * 64; U.v = VC + (size_t)(b * 8 + hd) * NPOS * 128;
        U.t0b = 0; U.t0e = NPOS / 64; U.t1b = 0; U.t1e = 0; U.qlat0 = qt * 128; U.sink0 = U.sink1 = 0.f;
        U.o0 = Oo + row0 * 1024 + hd * 128; U.o1 = U.o0;
        attn_unit<128, 2, AF>(p, lds, U, wave, lane);
        if (!AF) { conv_rounds(p, 1, cdone, cdone + 2, wave, lane); cdone += 2; }
    }
    if (!AF) conv_rounds(p, 1, cdone, crounds, wave, lane);
}

template <int CTRL> __device__ __forceinline__ float dppf(float v) { return __uint_as_float((unsigned)__builtin_amdgcn_update_dpp(0, (int)__float_as_uint(v), CTRL, 0xf, 0xf, true)); }
#define rlf(v, l) __uint_as_float((unsigned)__builtin_amdgcn_readlane((int)__float_as_uint(v), (l)))
__device__ __forceinline__ float max8(float v) { v = fmaxf(v, dppf<0xB1>(v)); v = fmaxf(v, dppf<0x4E>(v)); v = fmaxf(v, dppf<0x141>(v)); return v; }
__device__ __forceinline__ float max64(float v) { v = max8(v); v = fmaxf(v, dppf<0x140>(v));
    const float a = rlf(v, 0), b = rlf(v, 16), c = rlf(v, 32), d = rlf(v, 48);
    return fmaxf(fmaxf(a, b), fmaxf(c, d)); }
__device__ __forceinline__ float sum64(float v) { v += dppf<0xB1>(v); v += dppf<0x4E>(v); v += dppf<0x141>(v); v += dppf<0x140>(v);
    return (rlf(v, 0) + rlf(v, 16)) + (rlf(v, 32) + rlf(v, 48)); }
__device__ __forceinline__ float ss16(const f32x4 (&v)[4]) {
    float s = 0.f;
#pragma unroll
    for (int i = 0; i < 4; ++i) s += v[i][0] * v[i][0] + v[i][1] * v[i][1] + v[i][2] * v[i][2] + v[i][3] * v[i][3];
    return sum64(s); }
constexpr int RT_PITCH = 2064;
template <int FAKE>
__device__ __forceinline__ void ph_postmix_route(const Params& p, LAS uchar* lds, int wave, int lane, int l, const bf16_t* PO, uchar* H2, int row_lo, float* xdummy) {
    const float* ng = p.in[6] + (size_t)l * 4 * DM;
    const float* mod = (const float*)(p.ws + WS_MOD) + (size_t)l * 5 * 6144;
    const bf16_t* RWt = (const bf16_t*)(p.ws + WS_RW) + (size_t)l * 64 * 1024;
    const float* rb = p.in[17] + l * 64;
    const int grp = blockIdx.x & 15;
    unsigned* cnt = (unsigned*)(p.ws + CNT_OFF + (FAKE ? CNT_SET : 0)) + (size_t)((l * 16 + grp) * 64) * 16;
    int* list = (int*)(p.ws + WS_LIST);
    float* slotw = (float*)(p.ws + WS_SLOTW);
    bf16_t* XB = (bf16_t*)(p.ws + WS_XB);
    LAS uchar* T = lds;
    LAS float* P = (LAS float*)(lds + 16 * RT_PITCH);
    bf16x8 wb[4][4];
#pragma unroll
    for (int ks = 0; ks < 4; ++ks)
#pragma unroll
        for (int nb = 0; nb < 4; ++nb) wb[ks][nb] = *(const bf16x8*)(RWt + (size_t)(nb * 16 + (lane & 15)) * 1024 + wave * 128 + ks * 32 + 8 * (lane >> 4));
    const float rbias = rb[lane];
    f32x4 g1v[4], g2v[4];
#pragma unroll
    for (int i = 0; i < 4; ++i) { const int c = 8 * lane + 512 * (i >> 1) + 4 * (i & 1); g1v[i] = ld4(ng + DM + c); g2v[i] = ld4(ng + 2 * DM + c); }
    const int ngroups = (TT - row_lo) / 16;
    for (int rg = blockIdx.x; rg < ngroups; rg += gridDim.x) {
        const int row0 = row_lo + rg * 16, mr = mod_row(row0);
        f32x4 y[2][4], x[2][4];
#pragma unroll
        for (int rr = 0; rr < 2; ++rr) {
            const int row = row0 + wave * 2 + rr;
            const float* xs = (row < TCTX) ? p.in[2] + (size_t)row * DM : p.in[0] + (size_t)(row - TCTX) * DM;
#pragma unroll
            for (int hf = 0; hf < 2; ++hf) { const int c = 8 * lane + 512 * hf;
                const u32x4 w = *(const u32x4*)(PO + (size_t)row * DM + c);
                y[rr][2 * hf] = (f32x4){bf_lo(w.x), bf_hi(w.x), bf_lo(w.y), bf_hi(w.y)}; y[rr][2 * hf + 1] = (f32x4){bf_lo(w.z), bf_hi(w.z), bf_lo(w.w), bf_hi(w.w)};
                if (l == 0) { x[rr][2 * hf] = ld4(xs + c); x[rr][2 * hf + 1] = ld4(xs + c + 4); }
                else { const u32x4 xw = *(const u32x4*)(XB + (size_t)row * DM + c);
                    x[rr][2 * hf] = (f32x4){bf_lo(xw.x), bf_hi(xw.x), bf_lo(xw.y), bf_hi(xw.y)}; x[rr][2 * hf + 1] = (f32x4){bf_lo(xw.z), bf_hi(xw.z), bf_lo(xw.w), bf_hi(xw.w)}; } }
        }
        f32x4 gt[4], sc[4], sh[4];
#pragma unroll
        for (int i = 0; i < 4; ++i) { const int c = 8 * lane + 512 * (i >> 1) + 4 * (i & 1);
            gt[i] = ld4(mod + mr * 6144 + 2048 + c); sh[i] = ld4(mod + mr * 6144 + 3072 + c); sc[i] = ld4(mod + mr * 6144 + 4096 + c); }
#pragma unroll
        for (int rr = 0; rr < 2; ++rr) {
            const int li = wave * 2 + rr, row = row0 + li;
            bf16_t* xd = FAKE ? (bf16_t*)xdummy + (size_t)row * DM : XB + (size_t)row * DM;
            const float rs1 = rsqrtf(ss16(y[rr]) * (1.0f / DM) + EPS);
#pragma unroll
            for (int i = 0; i < 4; ++i) { const int c = 8 * lane + 512 * (i >> 1) + 4 * (i & 1);
                x[rr][i] = x[rr][i] + gt[i] * (y[rr][i] * rs1 * g1v[i]); }
#pragma unroll
            for (int hf = 0; hf < 2; ++hf) { const f32x4 &xa = x[rr][2 * hf], &xb_ = x[rr][2 * hf + 1];
                u32x4 w; w.x = cvt_pk(xa[0], xa[1]); w.y = cvt_pk(xa[2], xa[3]); w.z = cvt_pk(xb_[0], xb_[1]); w.w = cvt_pk(xb_[2], xb_[3]);
                *(u32x4*)(xd + 8 * lane + 512 * hf) = w; }
            const float rs2 = rsqrtf(ss16(x[rr]) * (1.0f / DM) + EPS);
#pragma unroll
            for (int hf = 0; hf < 2; ++hf) { const int c = 8 * lane + 512 * hf;
                const f32x4 h0 = x[rr][2 * hf] * rs2 * g2v[2 * hf] * (1.0f + sc[2 * hf]) + sh[2 * hf], h1 = x[rr][2 * hf + 1] * rs2 * g2v[2 * hf + 1] * (1.0f + sc[2 * hf + 1]) + sh[2 * hf + 1];
                u32x4 w; w.x = cvt_pk(h0[0], h0[1]); w.y = cvt_pk(h0[2], h0[3]); w.z = cvt_pk(h1[0], h1[1]); w.w = cvt_pk(h1[2], h1[3]);
                { u32x2 wq; wq.x = pk_fp8x4(h0[0] * H2_QS, h0[1] * H2_QS, h0[2] * H2_QS, h0[3] * H2_QS); wq.y = pk_fp8x4(h1[0] * H2_QS, h1[1] * H2_QS, h1[2] * H2_QS, h1[3] * H2_QS);
                  *(u32x2*)(H2 + (size_t)row * DM + c) = wq; }
                *(LAS u32x4*)(T + li * RT_PITCH + c * 2) = w; }
        }
        __syncthreads();
        f32x4 acc[4];
#pragma unroll
        for (int nb = 0; nb < 4; ++nb) acc[nb] = (f32x4){0.f, 0.f, 0.f, 0.f};
#pragma unroll
        for (int ks = 0; ks < 4; ++ks) {
            const bf16x8 a = *(const LAS bf16x8*)(T + (lane & 15) * RT_PITCH + (wave * 128 + ks * 32 + 8 * (lane >> 4)) * 2);
#pragma unroll
            for (int nb = 0; nb < 4; ++nb) acc[nb] = __builtin_amdgcn_mfma_f32_16x16x32_bf16(a, wb[ks][nb], acc[nb], 0, 0, 0);
        }
#pragma unroll
        for (int nb = 0; nb < 4; ++nb)
#pragma unroll
            for (int r = 0; r < 4; ++r) P[(wave * 16 + (lane >> 4) * 4 + r) * 64 + nb * 16 + (lane & 15)] = acc[nb][r];
        __syncthreads();
#pragma unroll
        for (int rr = 0; rr < 2; ++rr) {
            const int li = wave * 2 + rr, row = row0 + li;
            float lg = 0.f;
#pragma unroll
            for (int w = 0; w < 8; ++w) lg += P[(w * 16 + li) * 64 + lane];
            const float score = 1.0f / (1.0f + __expf(-lg));
            const float sel = score + rbias;
            const float m1 = max8(sel);
            const unsigned long long bal = __ballot(sel == m1);
            const unsigned gb = (unsigned)(bal >> (lane & 56)) & 0xFFu;
            const int first = __builtin_ctz(gb | 0x100u);
            const float m2 = max8(((lane & 7) == first) ? -INFINITY : sel);
            const float gs = m1 + m2;
            const int g = lane >> 3; int rank = 0;
#pragma unroll
            for (int gp = 0; gp < 8; ++gp) { const float o = rlf(gs, gp * 8); rank += ((o > gs) || (o == gs && gp < g)) ? 1 : 0; }
            float v = (rank < 4) ? sel : -1e30f;
            bool chosen = false;
#pragma unroll
            for (int it = 0; it < 8; ++it) {
                const float mx = max64(v);
                const unsigned long long b2 = __ballot(v == mx);
                const int f = __builtin_ctzll(b2);
                if (lane == f) { chosen = true; v = -INFINITY; }
            }
            const float ssum = sum64(chosen ? score : 0.f);
            const unsigned long long cb = __ballot(chosen);
            if (chosen) {
                const int k = __popcll(cb & ((1ull << lane) - 1ull));
                const int slot = row * 8 + k;
                const unsigned pos = atomicAdd(&cnt[lane * 16], 1u);
                list[(size_t)(lane * 16 + grp) * LCAP + pos] = slot;
                slotw[slot] = score / ssum * 2.5f;
            }
        }
        __syncthreads();
    }
}

__device__ __forceinline__ int moe_prefix(const Params& p, LAS int* pre, LAS int* seg, int l, int row_lo) {
    const unsigned* cnt = (const unsigned*)(p.ws + CNT_OFF) + (size_t)(l * 16 * 64) * 16;
    __syncthreads();
    if (threadIdx.x < 64) {
        const int e = threadIdx.x; int acc = 0;
        unsigned c16[16];
#pragma unroll
        for (int g = 0; g < 16; ++g) c16[g] = cnt[(size_t)(g * 64 + e) * 16];
#pragma unroll
        for (int g = 0; g < 16; ++g) { seg[e * 17 + g] = acc; acc += (int)c16[g]; }
        seg[e * 17 + 16] = acc;
        const int tl = (acc + 127) >> 7; int incl = tl;
#pragma unroll
        for (int d = 1; d < 64; d <<= 1) { const int o = __shfl_up(incl, d); if (e >= d) incl += o; }
        pre[e] = incl - tl;
        if (e == 63) { pre[64] = incl; pre[65] = incl + ((TT - row_lo) >> 7); }
    }
    __syncthreads();
    return pre[65];
}
__device__ __forceinline__ void moe_tile_rows(const Params& p, LAS int* pre, LAS int* seg, LAS int* sl, int l, int row_lo, int mg, int& e_out, int& nvalid) {
    const int* list = (const int*)(p.ws + WS_LIST);
    int e = 0;
    for (int q = 1; q <= 64; ++q) e = (pre[q] <= mg) ? q : e;
    const int lm = mg - pre[e], count = (e < 64) ? seg[e * 17 + 16] : (TT - row_lo);
    const int nv = (count - lm * 128) < 128 ? (count - lm * 128) : 128;
    __syncthreads();
    if (threadIdx.x < 128) {
        int idx = lm * 128 + (int)threadIdx.x; if (idx >= count) idx = count - 1;
        int v;
        if (e < 64) { int g = 0;
#pragma unroll
            for (int q = 1; q < 16; ++q) g = (seg[e * 17 + q] <= idx) ? q : g;
            v = list[(size_t)(e * 16 + g) * LCAP + (idx - seg[e * 17 + g])]; }
        else v = NSLOT_R + row_lo + idx;
        sl[threadIdx.x] = v;
    }
    __syncthreads();
    e_out = e; nvalid = nv;
}
template <int FAKE>
__device__ __forceinline__ void ph_moe(const Params& p, LAS uchar* lds, int wave, int lane, int l, const uchar* H2, int row_lo) {
    constexpr int ST1 = 40960, ST2 = 16384, P2OFF = 65536;
    LAS int* pre = (LAS int*)(lds + LDS_SMALL); LAS int* sl = pre + 128; LAS int* seg = pre + 256;
    uchar* Yk = p.ws + WS_BIG + BIG_YK; uchar* Ysh = p.ws + WS_BIG + BIG_YSH;
    uchar* trash = p.ws + WS_TRASH;
    const float* slotw = (const float*)(p.ws + WS_SLOTW);
    const int r32 = lane & 31, h = lane >> 5, wm = wave >> 2, wn = wave & 3, sw = (r32 >> 2) & 3;
    const int c0 = ((2 * h) ^ sw) << 4, c1 = ((2 * h + 1) ^ sw) << 4;
    const int ntile = moe_prefix(p, pre, seg, l, row_lo);
    for (int u = blockIdx.x; u < ntile; u += gridDim.x) {
        int e, nv; moe_tile_rows(p, pre, seg, sl, l, row_lo, u, e, nv);
        const uchar* W13 = p.ws + WS_WE + (size_t)((FAKE & 2) ? 0 : e) * WE_STRIDE;
        const uchar* W2 = W13 + (size_t)512 * 1024;
        const uchar* ap; const uchar* bp[4];
        { const int s = sl[wave * 16 + (lane >> 2)]; const int trow = (FAKE & 4) ? (row_lo + ((u * 128 + wave * 16 + (lane >> 2)) % (TT - row_lo))) : (s < NSLOT_R) ? (s >> 3) : (s - NSLOT_R);
          ap = H2 + (size_t)trow * DM + dma_chunk(lane) * 16; }
#pragma unroll
        for (int i = 0; i < 4; ++i) bp[i] = W13 + (size_t)((wave * 4 + i) * 16 + (lane >> 2)) * 1024 + dma_chunk(lane) * 16;
        f32x16 acc1[4][2]; zero_acc<4>(acc1);
#define P1_ISSUE(stg, kb) do { dma16(ap + (kb), (stg) + wave * 1024); _Pragma("unroll") for (int i_ = 0; i_ < 4; ++i_) dma16(bp[i_] + (kb), (stg) + 8192 + (wave * 4 + i_) * 1024); } while (0)
        P1_ISSUE(lds, 0); P1_ISSUE(lds + ST1, 64);
        const bool upper = wave >= 4;
        VMWAIT(5);
        if (upper) BAR_RAW();
#define LD8(dst_, base_) do { const i32x4 lo_ = *(const LAS i32x4*)((base_) + c0), hi_ = *(const LAS i32x4*)((base_) + c1); \
            dst_ = __builtin_shufflevector(lo_, hi_, 0, 1, 2, 3, 4, 5, 6, 7); } while (0)
#define MFMA8(a_, b_, c_) __builtin_amdgcn_mfma_scale_f32_32x32x64_f8f6f4(a_, b_, c_, 0, 0, 0, 0, 0, 0)
        { int cur = 0, nxt = 2;
          const int a_base = (wm * 64 + r32) * 64, b_base = 8192 + (wn * 128 + r32) * 64;
          for (int kt = 0; kt < 16; ++kt) {
            BAR_RAW();
            if (kt + 2 < 16) P1_ISSUE(lds + nxt * ST1, (kt + 2) * 64);
            const LAS uchar* st = lds + cur * ST1;
            i32x8 a[2], b[4];
            LD8(a[0], st + a_base); LD8(a[1], st + a_base + 2048);
#pragma unroll
            for (int jn = 0; jn < 4; ++jn) LD8(b[jn], st + b_base + jn * 2048);
            if (kt + 2 < 16) VLWAIT(5); else VLWAIT(0);
            __builtin_amdgcn_sched_barrier(0);
            BAR_RAW();
            __builtin_amdgcn_sched_barrier(0);
            __builtin_amdgcn_s_setprio(1);
#pragma unroll
            for (int jn = 0; jn < 4; ++jn) { acc1[jn][0] = MFMA8(b[jn], a[0], acc1[jn][0]); acc1[jn][1] = MFMA8(b[jn], a[1], acc1[jn][1]); }
            __builtin_amdgcn_s_setprio(0);
            __builtin_amdgcn_sched_barrier(0);
            cur = (cur == 2) ? 0 : cur + 1; nxt = (nxt == 2) ? 0 : nxt + 1;
          } }
        if (!upper) BAR_RAW();
#undef P1_ISSUE
        asm volatile("" ::: "memory");
        __builtin_amdgcn_s_barrier();
        asm volatile("" ::: "memory");
        uchar* dst[2]; float wgt[2];
#pragma unroll
        for (int im = 0; im < 2; ++im) { const int ri = wm * 64 + im * 32 + r32, s = sl[ri];
            wgt[im] = (s < NSLOT_R) ? slotw[s] : 1.0f;
            dst[im] = (ri < nv && !(FAKE & 1)) ? (((s < NSLOT_R) ? Yk + (size_t)s * DM : Ysh + (size_t)(s - NSLOT_R) * DM) + wn * 64) : trash + wn * 64; }
        const uchar* bp2[2];
#pragma unroll
        for (int i = 0; i < 2; ++i) bp2[i] = W2 + (size_t)((wave * 2 + i) * 16 + (lane >> 2)) * 256 + dma_chunk(lane) * 16;
#define P2_ISSUE(t_) do { const int t__ = (t_); const size_t o__ = (size_t)(t__ >> 2) * 65536 + (size_t)(t__ & 3) * 64; \
        dma16(bp2[0] + o__, lds + P2OFF + (t__ & 3) * ST2 + (wave * 2) * 1024); dma16(bp2[1] + o__, lds + P2OFF + (t__ & 3) * ST2 + (wave * 2 + 1) * 1024); } while (0)
        P2_ISSUE(0); P2_ISSUE(1); P2_ISSUE(2);
#pragma unroll
        for (int im = 0; im < 2; ++im) {
            const int row = wm * 64 + im * 32 + r32;
#pragma unroll
            for (int hh = 0; hh < 2; ++hh) { f32x16 o;
                constexpr float DQ = 1.0f / (H2_QS * W13_QS);
#pragma unroll
                for (int r = 0; r < 16; ++r) { const float a = acc1[2 * hh][im][r] * DQ, b = acc1[2 * hh + 1][im][r] * (DQ * HMID_QS); o[r] = a / (1.0f + __expf(-a)) * b; }
                unsigned q4[4];
#pragma unroll
                for (int rq = 0; rq < 4; ++rq) q4[rq] = pk_fp8x4(o[4 * rq], o[4 * rq + 1], o[4 * rq + 2], o[4 * rq + 3]);
                const auto ra = __builtin_amdgcn_permlane32_swap(q4[0], q4[2], false, false);
                const auto rb = __builtin_amdgcn_permlane32_swap(q4[1], q4[3], false, false);
                u32x4 w; w.x = ra[0]; w.y = ra[1]; w.z = rb[0]; w.w = rb[1];
                *(LAS u32x4*)(lds + wn * 8192 + row * 64 + (((2 * hh + h) ^ sw) << 4)) = w;
            }
        }
        f32x16 acc2[2][2]; zero_acc<2>(acc2);
        asm volatile("" : "+v"(wgt[0]), "+v"(wgt[1]));
        asm volatile("s_waitcnt lgkmcnt(0)" ::: "memory");
        { const int a_base = (wm * 64 + r32) * 64, b_base = (wn * 64 + r32) * 64;
          constexpr float DQ2 = 1.0f / (HMID_QS * W2_QS);
          for (int t = 0; t < 16; ++t) {
            const int nt = t >> 2, kt = t & 3;
            if (!(nt > 0 && kt < 3)) { if (t + 2 < 16) VMWAIT(4); else if (t + 1 < 16) VMWAIT(2); else VMWAIT(0); }
            __builtin_amdgcn_s_barrier();
            asm volatile("" ::: "memory");
            if (t + 3 < 16) P2_ISSUE(t + 3);
            const LAS uchar* st = lds + P2OFF + (t & 3) * ST2;
            const LAS uchar* ha = lds + kt * 8192;
            i32x8 a0, a1, b0, b1;
            LD8(a0, ha + a_base); LD8(a1, ha + a_base + 2048);
            LD8(b0, st + b_base); LD8(b1, st + b_base + 2048);
            acc2[0][0] = MFMA8(b0, a0, acc2[0][0]); acc2[0][1] = MFMA8(b0, a1, acc2[0][1]);
            acc2[1][0] = MFMA8(b1, a0, acc2[1][0]); acc2[1][1] = MFMA8(b1, a1, acc2[1][1]);
            if (kt == 3) {
                VMWAIT(0);
#pragma unroll
                for (int im = 0; im < 2; ++im)
#pragma unroll
                    for (int jn = 0; jn < 2; ++jn) {
                        const f32x16& v = acc2[jn][im]; const float w = wgt[im] * DQ2;
                        unsigned q4[4];
#pragma unroll
                        for (int rq = 0; rq < 4; ++rq) q4[rq] = pk_fp8x4(v[4 * rq] * w, v[4 * rq + 1] * w, v[4 * rq + 2] * w, v[4 * rq + 3] * w);
                        const auto ra = __builtin_amdgcn_permlane32_swap(q4[0], q4[2], false, false);
                        const auto rb = __builtin_amdgcn_permlane32_swap(q4[1], q4[3], false, false);
                        u32x4 q; q.x = ra[0]; q.y = ra[1]; q.z = rb[0]; q.w = rb[1];
                        *(u32x4*)(dst[im] + nt * 256 + jn * 32 + 16 * h) = q;
                    }
                zero_acc<2>(acc2);
            }
          } }
#undef LD8
#undef MFMA8
#undef P2_ISSUE
    }
}

struct CombRow { u32x2 ysh[2]; u32x2 yk[8][2]; u32x4 x[2]; };
__device__ __forceinline__ void comb_load(CombRow& R, const uchar* Yk, const uchar* Ysh, const bf16_t* xp, int row, int lane) {
#pragma unroll
    for (int hf = 0; hf < 2; ++hf) { const int c = 8 * lane + 512 * hf;
        R.ysh[hf] = __builtin_nontemporal_load((const u32x2*)(Ysh + (size_t)row * DM + c));
#pragma unroll
        for (int k = 0; k < 8; ++k) R.yk[k][hf] = __builtin_nontemporal_load((const u32x2*)(Yk + ((size_t)row * 8 + k) * DM + c));
        R.x[hf] = *(const u32x4*)(xp + c); }
}
__device__ __forceinline__ void acc_bf8(f32x4& a, f32x4& b, const u32x2 w) { a += fp8x4_f32(w.x); b += fp8x4_f32(w.y); }
template <bool LAST, int FAKE>
__device__ __forceinline__ void ph_combine(const Params& p, int wave, int lane, int l, int row_lo, float* xdummy) {
    const int nw = gridDim.x * 8, gw = blockIdx.x * 8 + wave;
    const float* ng = p.in[6] + (size_t)l * 4 * DM;
    const float* mod = (const float*)(p.ws + WS_MOD) + (size_t)l * 5 * 6144;
    const uchar* Yk = p.ws + WS_BIG + BIG_YK; const uchar* Ysh = p.ws + WS_BIG + BIG_YSH;
    bf16_t* XB = (bf16_t*)(p.ws + WS_XB);
    bf16_t* Hn = (bf16_t*)(p.ws + WS_BIG + L1_H);
    {
        const int r_lo = row_lo + (int)((long long)gw * (TT - row_lo) / nw), r_hi = row_lo + (int)((long long)(gw + 1) * (TT - row_lo) / nw);
        int mr = -1;
        f32x4 g3[4], gt[4];
#pragma unroll
        for (int i = 0; i < 4; ++i) { const int c = 8 * lane + 512 * (i >> 1) + 4 * (i & 1); g3[i] = ld4(ng + 3 * DM + c); gt[i] = g3[i]; }
#pragma unroll 1
        for (int row = r_lo; row < r_hi; ++row) {
            {
                if (mod_row(row) != mr) { mr = mod_row(row);
#pragma unroll
                    for (int i = 0; i < 4; ++i) { const int c = 8 * lane + 512 * (i >> 1) + 4 * (i & 1); gt[i] = ld4(mod + mr * 6144 + 5120 + c); } }
                CombRow C;
                comb_load(C, Yk, Ysh, XB + (size_t)row * DM, row, lane);
                f32x4 y[4];
#pragma unroll
                for (int hf = 0; hf < 2; ++hf) { y[2 * hf] = (f32x4){0.f, 0.f, 0.f, 0.f}; y[2 * hf + 1] = (f32x4){0.f, 0.f, 0.f, 0.f};
                    acc_bf8(y[2 * hf], y[2 * hf + 1], C.ysh[hf]);
#pragma unroll
                    for (int k = 0; k < 8; ++k) acc_bf8(y[2 * hf], y[2 * hf + 1], C.yk[k][hf]); }
                const float rs = rsqrtf(ss16(y) * (1.0f / DM) + EPS);
                f32x4 x[4];
#pragma unroll
                for (int hf = 0; hf < 2; ++hf) { const u32x4 xw = C.x[hf];
                    x[2 * hf] = (f32x4){bf_lo(xw.x), bf_hi(xw.x), bf_lo(xw.y), bf_hi(xw.y)} + gt[2 * hf] * (y[2 * hf] * rs * g3[2 * hf]);
                    x[2 * hf + 1] = (f32x4){bf_lo(xw.z), bf_hi(xw.z), bf_lo(xw.w), bf_hi(xw.w)} + gt[2 * hf + 1] * (y[2 * hf + 1] * rs * g3[2 * hf + 1]); }
                if (LAST) {
                    float* xq = FAKE ? xdummy + (size_t)row * DM : p.out + (size_t)(row - TCTX) * DM;
#pragma unroll
                    for (int i = 0; i < 4; ++i) *(f32x4*)(xq + 8 * lane + 512 * (i >> 1) + 4 * (i & 1)) = x[i];
                } else {
                    bf16_t* xq = FAKE ? (bf16_t*)xdummy + (size_t)row * DM : XB + (size_t)row * DM;
#pragma unroll
                    for (int hf = 0; hf < 2; ++hf) { u32x4 w; w.x = cvt_pk(x[2 * hf][0], x[2 * hf][1]); w.y = cvt_pk(x[2 * hf][2], x[2 * hf][3]);
                        w.z = cvt_pk(x[2 * hf + 1][0], x[2 * hf + 1][1]); w.w = cvt_pk(x[2 * hf + 1][2], x[2 * hf + 1][3]);
                        *(u32x4*)(xq + 8 * lane + 512 * hf) = w; }
                }
                if (!LAST) {
                    const float rs2 = rsqrtf(ss16(x) * (1.0f / DM) + EPS);
#pragma unroll
                    for (int hf = 0; hf < 2; ++hf) { const int c = 8 * lane + 512 * hf;
                        const f32x4 h0 = x[2 * hf] * rs2 * ld4(ng + 4 * DM + c) * (1.0f + ld4(mod + 5 * 6144 + mr * 6144 + 1024 + c)) + ld4(mod + 5 * 6144 + mr * 6144 + c);
                        const f32x4 h1 = x[2 * hf + 1] * rs2 * ld4(ng + 4 * DM + c + 4) * (1.0f + ld4(mod + 5 * 6144 + mr * 6144 + 1024 + c + 4)) + ld4(mod + 5 * 6144 + mr * 6144 + c + 4);
                        u32x4 w; w.x = cvt_pk(h0[0], h0[1]); w.y = cvt_pk(h0[2], h0[3]); w.z = cvt_pk(h1[0], h1[1]); w.w = cvt_pk(h1[2], h1[3]);
                        *(u32x4*)(Hn + (size_t)row * DM + c) = w; }
                }
            }
        }
    }
}

__device__ __forceinline__ void ph_l2probe(const uchar* base) {
    const u32x4* src = (const u32x4*)base; u32x4 acc = {0u, 0u, 0u, 0u};
    for (int rep = 0; rep < 64; ++rep)
        for (int i = threadIdx.x; i < (2 << 20) / 16; i += 512 * 8) {
#pragma unroll
            for (int j = 0; j < 8; ++j) { const u32x4 v = src[i + j * 512]; acc.x ^= v.x; acc.y ^= v.y; acc.z ^= v.z; acc.w ^= v.w; }
        }
    asm volatile("" :: "v"(acc));
}
__device__ __forceinline__ void ph_dump(const Params& p) {
    const bf16_t* src = (const bf16_t*)(p.ws + p.dbg_off); const size_t n = p.dbg_bytes / 2, NO = (size_t)TLAT * DM;
    for (size_t i = (size_t)blockIdx.x * 512 + threadIdx.x; i < NO; i += (size_t)gridDim.x * 512) {
        float a = 0.f;
        for (size_t j = i; j < n; j += NO) a += __uint_as_float((unsigned)src[j] << 16);
        p.out[i] = a;
    }
}
extern __shared__ __attribute__((aligned(16))) uchar smem_raw[];
__global__ void __launch_bounds__(512, 2) fwd(Params p) {
    LAS uchar* lds = (LAS uchar*)smem_raw;
    const int lane = threadIdx.x & 63, wave = __builtin_amdgcn_readfirstlane(threadIdx.x >> 6);
    const int lo = p.ph_lo, hi = p.ph_hi;
    XcdBarrier bar; bar.bar = (unsigned*)(p.ws + p.bar_off); bar.x = 0; bar.st = (volatile LAS unsigned*)(lds + LDS_BAR);
    if (hi - lo > 1) {
        if (threadIdx.x == 0) { *(LAS u32x4*)(lds + LDS_BAR) = (u32x4){0u, 0u, 0u, 0u}; }
        __syncthreads();
        bar = xcd_barrier_post((unsigned*)(p.ws + p.bar_off), (volatile LAS unsigned*)(lds + LDS_BAR));
#ifdef EXTRA_FIRST_BARRIER
        xcd_barrier(bar);
#endif
    }
#ifndef PHASE_MASK
#define PHASE_MASK 0xFFFF
#endif
#define IN(k) (((PHASE_MASK >> (k)) & 1) && lo <= (k) && (k) < hi)
#define SEAM(k) do { if (IN(k) && IN((k) + 1)) xcd_barrier(bar); } while (0)
#ifndef REPEAT_MASK
#define REPEAT_MASK 0
#endif
#define REP(k) if (((REPEAT_MASK >> (k)) & 1) && IN(k)) xcd_barrier(bar); if (((REPEAT_MASK >> (k)) & 1) && IN(k))
    uchar* big = p.ws + WS_BIG;
    if (IN(0)) ph_prologue(p, wave, lane);
    REP(0) ph_prologue(p, wave, lane);
    if (IN(1)) ph_h0(p, wave, lane);
#ifdef PROBE_L2_WS
    if (IN(1)) ph_l2probe(p.ws + WS_WD);
#endif
#ifdef PROBE_L2_IN
    if (IN(1)) ph_l2probe((const uchar*)p.in[18]);
#endif
    REP(1) ph_h0(p, wave, lane);
    SEAM(1);
    if (IN(2)) ph_inproj0(p, lds, wave, lane);
    REP(2) ph_inproj0(p, lds, wave, lane);
    SEAM(2);
    if (IN(3)) ph_attn0(p, lds, wave, lane);
    REP(3) ph_attn0(p, lds, wave, lane);
    SEAM(3);
    if (IN(4)) ph_outproj<2>(p, lds, wave, lane, (const bf16_t*)(big + L0_ACT), (const bf16_t*)(p.ws + WS_WD + WD_ABOUT), (bf16_t*)(big + L0_PO), 0);
    REP(4) ph_outproj<2>(p, lds, wave, lane, (const bf16_t*)(big + L0_ACT), (const bf16_t*)(p.ws + WS_WD + WD_ABOUT), (bf16_t*)(big + L0_PO), 0);
    SEAM(4);
#ifdef ROW_FAKE
    if (IN(5)) { ph_postmix_route<1>(p, lds, wave, lane, 0, (const bf16_t*)(big + L0_PO), big + L0_H2, 0, (float*)big); xcd_barrier(bar); }
#endif
    if (IN(5)) ph_postmix_route<0>(p, lds, wave, lane, 0, (const bf16_t*)(big + L0_PO), big + L0_H2, 0, nullptr);
    SEAM(5);
#ifdef MOE_FAKE
    if (IN(6)) { ph_moe<MOE_FAKE>(p, lds, wave, lane, 0, big + L0_H2, 0); xcd_barrier(bar); }
#endif
    if (IN(6)) ph_moe<0>(p, lds, wave, lane, 0, big + L0_H2, 0);
    SEAM(6);
#ifdef COMB_FAKE
    if (IN(8)) { ph_combine<false, 1>(p, wave, lane, 0, 0, (float*)(p.ws + WS_WE)); xcd_barrier(bar); }
#endif
    if (IN(8)) ph_combine<false, 0>(p, wave, lane, 0, 0, nullptr);
    SEAM(8);
    if (IN(9)) ph_inproj1(p, lds, wave, lane);
    REP(9) ph_inproj1(p, lds, wave, lane);
    SEAM(9);
#ifdef ATT_FAKE
    if (IN(10)) { ph_attn1<ATT_FAKE>(p, lds, wave, lane); xcd_barrier(bar); }
#endif
    if (IN(10)) ph_attn1<0>(p, lds, wave, lane);
    SEAM(10);
    if (IN(11)) ph_outproj<4>(p, lds, wave, lane, (const bf16_t*)(big + L1_O), (const bf16_t*)(p.ws + WS_WD + WD_COUT), (bf16_t*)(big + L1_PO), 4);
    REP(11) ph_outproj<4>(p, lds, wave, lane, (const bf16_t*)(big + L1_O), (const bf16_t*)(p.ws + WS_WD + WD_COUT), (bf16_t*)(big + L1_PO), 4);
    SEAM(11);
#ifdef ROW_FAKE
    if (IN(12)) { ph_postmix_route<1>(p, lds, wave, lane, 1, (const bf16_t*)(big + L1_PO), big + L1_H2, TCTX, (float*)big); xcd_barrier(bar); }
#endif
    if (IN(12)) ph_postmix_route<0>(p, lds, wave, lane, 1, (const bf16_t*)(big + L1_PO), big + L1_H2, TCTX, nullptr);
    SEAM(12);
#ifdef MOE_FAKE
    if (IN(13)) { ph_moe<MOE_FAKE>(p, lds, wave, lane, 1, big + L1_H2, TCTX); xcd_barrier(bar); }
#endif
    if (IN(13)) ph_moe<0>(p, lds, wave, lane, 1, big + L1_H2, TCTX);
    SEAM(13);
#ifdef COMB_FAKE
    if (IN(15)) { ph_combine<true, 1>(p, wave, lane, 1, TCTX, (float*)(p.ws + WS_WE)); xcd_barrier(bar); }
#endif
    if (IN(15)) ph_combine<true, 0>(p, wave, lane, 1, TCTX, nullptr);
    if (lo == 16) ph_dump(p);
#undef IN
#undef SEAM
}

extern "C" void kernel_launch(void* const* d_in, const int* in_sizes, int n_in, void* d_out, int out_size, void* d_ws, size_t ws_size, hipStream_t stream) {
    static int grid = 0;
    if (grid == 0) {
        if (n_in != 24 || out_size != TLAT * DM || ws_size < WS_TOTAL) { fprintf(stderr, "kernel_launch: unexpected shapes or workspace (%zu < %zu)\n", ws_size, (size_t)WS_TOTAL); grid = -1; return; }
        int dev = 0, cus = 0;
        if (hipGetDevice(&dev) != hipSuccess || hipDeviceGetAttribute(&cus, hipDeviceAttributeMultiprocessorCount, dev) != hipSuccess || cus < 1) { grid = -1; return; }
        if (hipFuncSetAttribute((const void*)fwd, hipFuncAttributeMaxDynamicSharedMemorySize, LDS_BYTES) != hipSuccess) { fprintf(stderr, "kernel_launch: hipFuncSetAttribute failed\n"); grid = -1; return; }
        int per_cu = 0;
        if (hipOccupancyMaxActiveBlocksPerMultiprocessor(&per_cu, (const void*)fwd, 512, LDS_BYTES) != hipSuccess || per_cu < 1) { fprintf(stderr, "kernel_launch: occupancy query says %d\n", per_cu); (void)hipGetLastError(); }
        grid = cus & ~7;
    }
    if (grid < 0) return;
    (void)hipMemsetAsync(d_ws, 0, CTL_BYTES, stream);
    Params p{};
    for (int i = 0; i < 24; ++i) p.in[i] = (const float*)d_in[i];
    p.out = (float*)d_out; p.ws = (uchar*)d_ws;
#if defined(DBG_K)
#ifndef DBG_SKIP
#define DBG_SKIP 0
#endif
    for (int k = 0; k <= DBG_K; ++k) { if ((DBG_SKIP >> k) & 1) continue; p.ph_lo = k; p.ph_hi = k + 1; hipLaunchKernelGGL(fwd, dim3(grid), dim3(512), LDS_BYTES, stream, p); }
    p.ph_lo = 16; p.ph_hi = 17; p.dbg_off = (size_t)(DBG_OFF); p.dbg_bytes = (size_t)(DBG_BYTES);
    hipLaunchKernelGGL(fwd, dim3(grid), dim3(512), LDS_BYTES, stream, p);
#elif N_LAUNCH_PER_PHASE
    for (int k = 0; k < 16; ++k) { p.ph_lo = k; p.ph_hi = k + 1; hipLaunchKernelGGL(fwd, dim3(grid), dim3(512), LDS_BYTES, stream, p); }
#elif defined(SEAM_MASK)
    { int lo = 0, li = 0;
      for (int k = 0; k < 16; ++k) if (k == 15 || !((SEAM_MASK >> k) & 1)) { p.ph_lo = lo; p.ph_hi = k + 1; p.bar_off = (size_t)li * 16384; ++li; lo = k + 1;
          hipLaunchKernelGGL(fwd, dim3(grid), dim3(512), LDS_BYTES, stream, p); } }
#else
    p.ph_lo = 0; p.ph_hi = 16;
    hipLaunchKernelGGL(fwd, dim3(grid), dim3(512), LDS_BYTES, stream, p);
#endif
}
```

```cpp
#include <hip/hip_runtime.h>
#include <stdint.h>
#include <stdio.h>

#ifndef N_LAUNCH_PER_PHASE
#define N_LAUNCH_PER_PHASE 0
#endif

#define LAS __attribute__((address_space(3)))
typedef unsigned short bf16_t;
typedef unsigned char uchar;
typedef short bf16x8 __attribute__((ext_vector_type(8)));
typedef short s16x4 __attribute__((ext_vector_type(4)));
typedef short v4i16_t __attribute__((ext_vector_type(4)));
typedef float f32x2 __attribute__((ext_vector_type(2)));
typedef float f32x4 __attribute__((ext_vector_type(4)));
typedef float f32x16 __attribute__((ext_vector_type(16)));
typedef unsigned u32x2 __attribute__((ext_vector_type(2)));
typedef unsigned u32x4 __attribute__((ext_vector_type(4)));
typedef int i32x4 __attribute__((ext_vector_type(4)));
typedef int i32x8 __attribute__((ext_vector_type(8)));

constexpr int DM = 1024, NBATCH = 4, SEQ = 4096, LCTX = 256, NPOS = LCTX + SEQ;
constexpr int TCTX = NBATCH * LCTX, TLAT = NBATCH * SEQ, TT = TCTX + TLAT;
constexpr int NSLOT_R = TT * 8;
constexpr float EPS = 1e-6f, LOG2E = 1.4426950408889634f, QSCALE = 0.125f * 1.4426950408889634f;
constexpr float LAMBDA_INIT = 0.35550906759f;
constexpr float Q_QS = 32.0f, K_QS = 4.0f;
constexpr int Q_E8M0 = 0x7A7A7A7A, K_E8M0 = 0x7D7D7D7D;
constexpr float V_QS = 4.0f, P_QS = 16.0f;
constexpr int V_E8M0 = 0x7D7D7D7D, P_E8M0 = 0x7B7B7B7B;
constexpr float P_OFF = 4.0f;
constexpr float ATT_THR = 4.0f;

constexpr size_t al4k(size_t x) { return (x + 4095) & ~(size_t)4095; }
constexpr size_t CNT_OFF = 16 * 16384, CNT_SET = 2 * 16 * 64 * 64, ADA_CTR_OFF = CNT_OFF + 2 * CNT_SET, CTL_BYTES = ADA_CTR_OFF + 1024;
constexpr int LCAP = TT / 16;
constexpr size_t WS_MOD = CTL_BYTES;
constexpr size_t WS_ADAP = WS_MOD + al4k((size_t)2 * 5 * 6144 * 4);
constexpr size_t WS_ROPE = WS_ADAP + al4k((size_t)192 * 8 * 5 * 64 * 4);
constexpr size_t WS_LAM = WS_ROPE + 8192;
constexpr size_t WS_WD = WS_LAM + 4096;
constexpr size_t WD_ABIN = 0, WD_ABOUT = (size_t)1536 * 1024 * 2, WD_CIN = WD_ABOUT + (size_t)1024 * 1024 * 2, WD_COUT = WD_CIN + (size_t)3072 * 1024 * 2,
                 WD_BYTES = WD_COUT + (size_t)1024 * 1024 * 2;
constexpr size_t WS_RW = WS_WD + WD_BYTES;
constexpr size_t WS_WE = WS_RW + (size_t)2 * 64 * 1024 * 2;
constexpr size_t WE_STRIDE = (size_t)512 * 1024 + (size_t)1024 * 256;
constexpr float W13_QS = 64.0f, W2_QS = 32.0f, H2_QS = 4.0f, HMID_QS = 8.0f;
constexpr size_t WS_XB = WS_WE + 65 * WE_STRIDE;
constexpr size_t WS_LIST = WS_XB + (size_t)TT * DM * 2;
constexpr size_t WS_SLOTW = WS_LIST + (size_t)64 * TT * 4;
constexpr size_t WS_TRASH = al4k(WS_SLOTW + (size_t)NSLOT_R * 4);
constexpr size_t WS_BIG = WS_TRASH + 4096;
constexpr size_t ACT_B = (size_t)TT * DM * 2;
constexpr size_t BIG_YK = 0, BIG_YSH = 5 * ACT_B, BIG_HMID = BIG_YSH + ACT_B, BIG_BYTES = BIG_HMID + 2 * ACT_B;
constexpr size_t WS_TOTAL = WS_BIG + BIG_BYTES;
constexpr size_t L0_ACT = 0, L0_QA = ACT_B, L0_QB = L0_QA + (size_t)TT * 512 * 2, L0_KA = L0_QB + (size_t)TT * 512 * 2;
constexpr size_t KV64_B = (size_t)NBATCH * 2 * NPOS * 64 * 2;
constexpr size_t L0_VA = L0_KA + KV64_B, L0_KB = L0_VA + KV64_B, L0_VB = L0_KB + KV64_B, L0_PO = L0_VB + KV64_B;
constexpr size_t L1_H = BIG_HMID, L1_QC = 0, L1_KC = ACT_B, L1_VC = 2 * ACT_B, L1_O = 3 * ACT_B, L1_PO = 4 * ACT_B;
constexpr size_t L0_H2 = BIG_HMID, L1_H2 = BIG_HMID + ACT_B;
static_assert(L0_PO + ACT_B <= BIG_YSH && 5 * ACT_B <= BIG_YSH && L1_H2 + ACT_B <= BIG_BYTES && (size_t)NSLOT_R * DM <= BIG_YSH, "aliases must stay inside the Yk region");

constexpr int LDS_SMALL = 4 * 32768, LDS_BAR = LDS_SMALL + 8192, LDS_BYTES = LDS_BAR + 16;
constexpr int RT_STRIDE = 1028;

struct Params { const float* in[24]; float* out; uchar* ws; int ph_lo, ph_hi; size_t dbg_off, dbg_bytes; size_t bar_off; };

#define XB_TMO      128
#define XB_XCNT(j)  (256  + 64 * (j))
#define XB_XSUB(j)  (1280 + 64 * (j))
#define XB_XGEN(j)  (2304 + 64 * (j))
#define XB_TOP      3328
#define XB_TOPGEN   3392
#define XCD_BAR_WORDS 3456
#define XB_SPIN_CAP (1u << 18)
__device__ __forceinline__ unsigned xb_ld(unsigned* p)              { return __hip_atomic_load(p, __ATOMIC_RELAXED, __HIP_MEMORY_SCOPE_AGENT); }
__device__ __forceinline__ unsigned xb_add(unsigned* p, unsigned v) { return __hip_atomic_fetch_add(p, v, __ATOMIC_RELAXED, __HIP_MEMORY_SCOPE_AGENT); }
__device__ __forceinline__ unsigned xb_xcc_id() { return (unsigned)__builtin_amdgcn_s_getreg((3 << 11) | 20) & 0xFu; }
#define XB_SPIN(cond, bar) do { unsigned _sp = 0; while (cond) { __builtin_amdgcn_s_sleep(1); \
    if ((++_sp & 255u) == 0u) { if (xb_ld(&(bar)[XB_TMO])) break; if (_sp > XB_SPIN_CAP) { atomicAdd(&(bar)[XB_TMO], 1u); break; } } } } while (0)
struct XcdBarrier { unsigned* bar; unsigned x; volatile LAS unsigned* st; };
__device__ __forceinline__ XcdBarrier xcd_barrier_post(unsigned* bar, volatile LAS unsigned* st) {
    XcdBarrier b; b.bar = bar; b.x = xb_xcc_id(); b.st = st;
    if (threadIdx.x == 0) (void)xb_add(&bar[XB_XCNT(b.x)], 1u);
    return b;
}
__device__ __forceinline__ void xcd_barrier_complete(unsigned* bar, unsigned x, unsigned& nloc, unsigned& nx) {
    const unsigned G = gridDim.x * gridDim.y * gridDim.z;
    unsigned sum, cnt, mine, sp = 0u;
    for (;;) {
        sum = 0u; cnt = 0u; mine = 0u;
#pragma unroll
        for (unsigned j = 0; j < 16; ++j) { const unsigned c = xb_ld(&bar[XB_XCNT(j)]); sum += c; cnt += (c > 0u) ? 1u : 0u; mine = (j == x) ? c : mine; }
        if (sum == G) break;
        __builtin_amdgcn_s_sleep(1);
        if ((++sp & 255u) == 0u) { if (xb_ld(&bar[XB_TMO])) break; if (sp > XB_SPIN_CAP) { atomicAdd(&bar[XB_TMO], 1u); break; } }
    }
    nloc = mine > 0u ? mine : 1u; nx = cnt > 0u ? cnt : 1u;
}
__device__ __forceinline__ void xcd_barrier(const XcdBarrier& b) {
    asm volatile("s_waitcnt vmcnt(0)" ::: "memory");
    __syncthreads();
    if (threadIdx.x == 0) {
        unsigned* bar = b.bar;
        __builtin_amdgcn_s_waitcnt(0);
        unsigned nloc = b.st[0], nx = b.st[1];
        if (nloc == 0u) { xcd_barrier_complete(bar, b.x, nloc, nx); b.st[0] = nloc; b.st[1] = nx; }
        const unsigned old = xb_add(&bar[XB_XSUB(b.x)], 1u);
        const unsigned gen = old / nloc;
        if (old + 1u == (gen + 1u) * nloc) {
            __builtin_amdgcn_fence(__ATOMIC_RELEASE, "agent");
            asm volatile("s_waitcnt vmcnt(0)" ::: "memory");
            const unsigned og = xb_add(&bar[XB_TOP], 1u);
            const unsigned tg = og / nx;
            if (og + 1u == (tg + 1u) * nx) xb_add(&bar[XB_TOPGEN], 1u);
            else XB_SPIN(xb_ld(&bar[XB_TOPGEN]) == tg, bar);
            __builtin_amdgcn_fence(__ATOMIC_ACQUIRE, "agent");
            xb_add(&bar[XB_XGEN(b.x)], 1u);
            asm volatile("s_waitcnt vmcnt(0)" ::: "memory");
        } else {
            XB_SPIN(xb_ld(&bar[XB_XGEN(b.x)]) == gen, bar);
            __builtin_amdgcn_fence(__ATOMIC_ACQUIRE, "agent");
            asm volatile("s_waitcnt vmcnt(0)" ::: "memory");
        }
    }
    __syncthreads();
}

#define MFMA32(a, b, c) __builtin_amdgcn_mfma_f32_32x32x16_bf16(a, b, c, 0, 0, 0)
typedef __bf16 bf16x2_t __attribute__((ext_vector_type(2)));
__device__ __forceinline__ unsigned cvt_pk(float lo, float hi) { const f32x2 f = {lo, hi}; return __builtin_bit_cast(unsigned, __builtin_convertvector(f, bf16x2_t)); }
__device__ __forceinline__ float bf_lo(unsigned w) { return __uint_as_float(w << 16); }
__device__ __forceinline__ float clamp_fp8(float x) { return __builtin_fminf(__builtin_fmaxf(x, -448.0f), 448.0f); }
__device__ __forceinline__ unsigned pk_fp8x4(float a, float b, float c, float d) {
    int w = __builtin_amdgcn_cvt_pk_fp8_f32(clamp_fp8(a), clamp_fp8(b), 0, false);
    return (unsigned)__builtin_amdgcn_cvt_pk_fp8_f32(clamp_fp8(c), clamp_fp8(d), w, true); }
__device__ __forceinline__ unsigned pk_fp8x4_nc(float a, float b, float c, float d) {
    int w = __builtin_amdgcn_cvt_pk_fp8_f32(a, b, 0, false);
    return (unsigned)__builtin_amdgcn_cvt_pk_fp8_f32(c, d, w, true); }
__device__ __forceinline__ f32x4 fp8x4_f32(unsigned w) {
    const auto lo = __builtin_amdgcn_cvt_pk_f32_fp8((int)w, false), hi = __builtin_amdgcn_cvt_pk_f32_fp8((int)w, true);
    return (f32x4){lo[0], lo[1], hi[0], hi[1]}; }
__device__ __forceinline__ float bf_hi(unsigned w) { return __uint_as_float(w & 0xffff0000u); }
__device__ __forceinline__ float wsum(float v) {
#pragma unroll
    for (int o = 32; o > 0; o >>= 1) v += __shfl_xor(v, o);
    return v; }
__device__ __forceinline__ float wmaxf(float v) {
#pragma unroll
    for (int o = 32; o > 0; o >>= 1) v = fmaxf(v, __shfl_xor(v, o));
    return v; }
__device__ __forceinline__ int crow(int r, int h) { return (r & 3) + 8 * (r >> 2) + 4 * h; }
__device__ __forceinline__ void dma16(const void* g, LAS uchar* lds_wave_base) {
    unsigned sv; const unsigned dst = (unsigned)__builtin_amdgcn_readfirstlane((int)(unsigned)(uintptr_t)lds_wave_base);
    asm volatile("s_mov_b32 %0, m0\n\ts_mov_b32 m0, %2\n\ts_nop 0\n\tglobal_load_lds_dwordx4 %1, off\n\ts_mov_b32 m0, %0" : "=&s"(sv) : "v"(g), "s"(dst) : "memory"); }
__device__ __forceinline__ void dma16nt(const void* g, LAS uchar* lds_wave_base) {
    __builtin_amdgcn_global_load_lds((const unsigned*)g, (LAS unsigned*)lds_wave_base, 16, 0, 2); }
__device__ __forceinline__ float siluf(float x) { return x / (1.0f + expf(-x)); }
__device__ __forceinline__ f32x4 ld4(const float* p) { return *(const f32x4*)p; }
__device__ __forceinline__ f32x4 ldbf4(const bf16_t* p) { const u32x2 w = *(const u32x2*)p; return (f32x4){bf_lo(w.x), bf_hi(w.x), bf_lo(w.y), bf_hi(w.y)}; }
__device__ __forceinline__ void stbf4(bf16_t* p, f32x4 v) { u32x2 w; w.x = cvt_pk(v[0], v[1]); w.y = cvt_pk(v[2], v[3]); *(u32x2*)p = w; }
__device__ __forceinline__ int mod_row(int row) { return row < TCTX ? 4 : (row - TCTX) >> 12; }

struct ConvDesc { const float* src; bf16_t* lo; bf16_t* hi; int ldn, ldk; uchar* qlo; uchar* qhi; float qs; };
__device__ __forceinline__ void conv_load(const ConvDesc& d, f32x4 (&v)[2][8], int lane) {
    const int n4 = lane & 15, q = lane >> 4;
#pragma unroll
    for (int half = 0; half < 2; ++half)
#pragma unroll
        for (int i = 0; i < 8; ++i) v[half][i] = __builtin_nontemporal_load((const f32x4*)(d.src + (size_t)(32 * half + 8 * q + i) * d.ldn + 4 * n4));
}
__device__ __forceinline__ void conv_store(const ConvDesc& d, const f32x4 (&v)[2][8], int lane) {
    const int n4 = lane & 15, q = lane >> 4;
#pragma unroll
    for (int half = 0; half < 2; ++half) {
        const int kb = 32 * half + 8 * q;
#pragma unroll
        for (int j = 0; j < 4; ++j) {
            const int n = 4 * n4 + j;
            bf16_t* drow = (n < 32) ? d.lo + (size_t)n * d.ldk : d.hi + (size_t)(n - 32) * d.ldk;
            u32x4 w; w.x = cvt_pk(v[half][0][j], v[half][1][j]); w.y = cvt_pk(v[half][2][j], v[half][3][j]); w.z = cvt_pk(v[half][4][j], v[half][5][j]); w.w = cvt_pk(v[half][6][j], v[half][7][j]);
            *(u32x4*)(drow + kb) = w;
        }
    }
}
__device__ __forceinline__ void conv_store_q8(const ConvDesc& d, const f32x4 (&v)[2][8], int lane) {
    const int n4 = lane & 15, q = lane >> 4; const float qs = d.qs;
#pragma unroll
    for (int half = 0; half < 2; ++half) {
        const int kb = 32 * half + 8 * q;
#pragma unroll
        for (int j = 0; j < 4; ++j) {
            const int n = 4 * n4 + j;
            uchar* drow = (n < 32) ? d.qlo + (size_t)n * d.ldk : d.qhi + (size_t)(n - 32) * d.ldk;
            u32x2 w; w.x = pk_fp8x4(v[half][0][j] * qs, v[half][1][j] * qs, v[half][2][j] * qs, v[half][3][j] * qs);
            w.y = pk_fp8x4(v[half][4][j] * qs, v[half][5][j] * qs, v[half][6][j] * qs, v[half][7][j] * qs);
            *(u32x2*)(drow + kb) = w;
        }
    }
}
__device__ __forceinline__ void conv_tile(const float* src, int ldn, int k0, int n0, bf16_t* dst_lo, bf16_t* dst_hi, int ldk, int lane) {
    ConvDesc d; d.src = src + (size_t)k0 * ldn + n0; d.lo = dst_lo + k0; d.hi = dst_hi + k0; d.ldn = ldn; d.ldk = ldk; d.qlo = nullptr; d.qhi = nullptr; d.qs = 0.f;
    f32x4 v[2][8];
    conv_load(d, v, lane); conv_store(d, v, lane);
}
__device__ __forceinline__ void conv_expert_desc(const Params& p, int l, int t, ConvDesc& d) {
    const int e = t / 192, ti = t % 192, part = ti >> 6, r = ti & 63;
    uchar* we = p.ws + WS_WE + (size_t)e * WE_STRIDE;
    d.lo = nullptr; d.hi = nullptr;
    if (part < 2) {
        const float* src = (e < 64) ? p.in[part == 0 ? 18 : 19] + ((size_t)(l * 64 + e) << 18) : p.in[part == 0 ? 21 : 22] + ((size_t)l << 18);
        const int kt = r >> 2, nt = r & 3;
        uchar* lo = we + (size_t)(128 * nt + (part ? 32 : 0)) * 1024;
        d.src = src + (size_t)(kt * 64) * 256 + nt * 64; d.qlo = lo + kt * 64; d.qhi = lo + 64 * 1024 + kt * 64; d.ldn = 256; d.ldk = 1024; d.qs = W13_QS;
    } else {
        const float* src = (e < 64) ? p.in[20] + ((size_t)(l * 64 + e) << 18) : p.in[23] + ((size_t)l << 18);
        const int kt = r >> 4, nt = r & 15;
        uchar* lo = we + (size_t)512 * 1024 + (size_t)(64 * nt) * 256;
        d.src = src + (size_t)(kt * 64) * 1024 + nt * 64; d.qlo = lo + kt * 64; d.qhi = lo + 32 * 256 + kt * 64; d.ldn = 1024; d.ldk = 256; d.qs = W2_QS;
    }
}
__device__ __forceinline__ void conv_dense_task(const Params& p, int t, int lane) {
    const float* src; int N; size_t off;
    if (t < 384) { src = p.in[7]; N = 1536; off = WD_ABIN; }
    else if (t < 640) { t -= 384; src = p.in[8]; N = 1024; off = WD_ABOUT; }
    else if (t < 1408) { t -= 640; src = p.in[12]; N = 3072; off = WD_CIN; }
    else { t -= 1408; src = p.in[13]; N = 1024; off = WD_COUT; }
    const int ntn = N / 64, kt = t / ntn, nt = t % ntn;
    bf16_t* lo = (bf16_t*)(p.ws + WS_WD + off) + (size_t)(64 * nt) * 1024;
    conv_tile(src, N, kt * 64, nt * 64, lo, lo + 32 * 1024, 1024, lane);
}
#define rlf0(v, l) __uint_as_float((unsigned)__builtin_amdgcn_readlane((int)__float_as_uint(v), (l)))
__device__ __forceinline__ void ada_task(const Params& p, int t, int lane) {
    const int kq = t & 7, lc = t >> 3, l = lc / 96, cg = lc % 96, col = cg * 64 + lane;
    const float* W = p.in[4] + (size_t)l * 1024 * 6144 + col;
    float acc[5] = {0.f, 0.f, 0.f, 0.f, 0.f};
#pragma unroll 1
    for (int kb = kq * 2; kb < kq * 2 + 2; ++kb) {
        float wv[64];
#pragma unroll
        for (int j = 0; j < 64; ++j) wv[j] = __builtin_nontemporal_load(W + (size_t)(kb * 64 + j) * 6144);
        float s[5];
#pragma unroll
        for (int r = 0; r < 4; ++r) s[r] = siluf(p.in[1][r * 1024 + kb * 64 + lane]);
        s[4] = siluf(p.in[3][kb * 64 + lane]);
        __builtin_amdgcn_sched_barrier(0);
#pragma unroll
        for (int j = 0; j < 64; ++j) {
#pragma unroll
            for (int r = 0; r < 5; ++r) acc[r] += rlf0(s[r], j) * wv[j];
        }
    }
    float* part = (float*)(p.ws + WS_ADAP) + ((size_t)(lc * 8 + kq) * 5) * 64 + lane;
#pragma unroll
    for (int r = 0; r < 5; ++r) __hip_atomic_store(part + r * 64, acc[r], __ATOMIC_RELAXED, __HIP_MEMORY_SCOPE_AGENT);
    asm volatile("s_waitcnt vmcnt(0)" ::: "memory");
    unsigned tick = 0;
    if (lane == 0) tick = __hip_atomic_fetch_add((unsigned*)(p.ws + ADA_CTR_OFF) + lc, 1u, __ATOMIC_RELAXED, __HIP_MEMORY_SCOPE_AGENT);
    tick = (unsigned)__builtin_amdgcn_readfirstlane((int)tick);
    if (tick == 7u) {
        float* mod = (float*)(p.ws + WS_MOD) + (size_t)l * 5 * 6144;
        const float bb = p.in[5][l * 6144 + col];
        const float* pb4 = (const float*)(p.ws + WS_ADAP) + ((size_t)(lc * 8) * 5) * 64 + lane;
#pragma unroll
        for (int r = 0; r < 5; ++r) { float a = bb;
#pragma unroll
            for (int q = 0; q < 8; ++q) a += __hip_atomic_load(pb4 + (q * 5 + r) * 64, __ATOMIC_RELAXED, __HIP_MEMORY_SCOPE_AGENT);
            mod[r * 6144 + col] = a; }
    }
}
__device__ __forceinline__ void misc_task(const Params& p, int i, int lane) {
    if (i < 16) {
        float* ct = (float*)(p.ws + WS_ROPE); float* st = ct + 1024;
        const int idx = lane + 64 * i, pos = idx >> 4, fi = idx & 15;
        const float inv = powf(10000.0f, -(float)fi / 16.0f), ang = (float)pos * inv;
        ct[idx] = cosf(ang); st[idx] = sinf(ang);
        return;
    }
    const float* lp = p.in[14];
    const float a = wsum(lp[lane] * lp[64 + lane]), b = wsum(lp[128 + lane] * lp[192 + lane]);
    if (lane == 0) *(float*)(p.ws + WS_LAM) = expf(a) - expf(b) + LAMBDA_INIT;
}
constexpr int CONV_T = 65 * 192, CV_A0 = 104 * 8 * 4, CV_B0 = CV_A0 + 224 * 8 * 1, CV_A1 = 160 * 8 * 2;
__device__ __forceinline__ void conv_strided(const Params& p, int l, int tbase, int w, int stride, int n, int tend, int lane) {
    for (int i = 0; i < n; i += 2) {
        const int t0 = tbase + w + i * stride, t1 = t0 + stride; const bool b0 = t0 < tend, b1 = (i + 1 < n) && t1 < tend;
        ConvDesc da, db; f32x4 va[2][8], vb[2][8];
        if (b0) { conv_expert_desc(p, l, t0, da); conv_load(da, va, lane); }
        if (b1) { conv_expert_desc(p, l, t1, db); conv_load(db, vb, lane); }
        if (b0) conv_store_q8(da, va, lane);
        if (b1) conv_store_q8(db, vb, lane);
    }
}
__device__ __forceinline__ int conv_base(int l) { return (gridDim.x == 256) ? (l == 0 ? CV_B0 : CV_A1) : 0; }
__device__ __forceinline__ void conv_rounds(const Params& p, int l, int i0, int i1, int wave, int lane) {
    const int nw = gridDim.x * 8, gw = wave * gridDim.x + blockIdx.x;
    if (i1 > i0) conv_strided(p, l, conv_base(l) + i0 * nw, gw, nw, i1 - i0, CONV_T, lane);
}
__device__ __forceinline__ void ph_prologue(const Params& p, int wave, int lane) {
    const int nw = gridDim.x * 8, gw = wave * gridDim.x + blockIdx.x;
    constexpr int T_ADA = 1536, T_MISC = T_ADA + 17, T_DENSE = T_MISC + 1664, T_RW = T_DENSE + 32, T_ALL = T_RW;
    const bool split = nw >= T_ADA + 256;
    if (split && gw < T_ADA) { ada_task(p, gw, lane); return; }
    for (int t = split ? T_ADA + (gw - T_ADA) : gw; t < T_ALL; t += split ? nw - T_ADA : nw) {
        if (t < T_ADA) ada_task(p, t, lane);
        else if (t < T_MISC) misc_task(p, t - T_ADA, lane);
        else if (t < T_DENSE) conv_dense_task(p, t - T_MISC, lane);
        else { const int q = t - T_DENSE, rl = q >> 4, kt = q & 15; bf16_t* lo = (bf16_t*)(p.ws + WS_RW) + (size_t)rl * 64 * 1024;
            conv_tile(p.in[16] + (size_t)rl * 1024 * 64, 64, kt * 64, 0, lo, lo + 32 * 1024, 1024, lane); }
    }
}

__device__ __forceinline__ float row_ss(const f32x4 (&v)[4]) {
    float s = 0.f;
#pragma unroll
    for (int i = 0; i < 4; ++i) s += v[i][0] * v[i][0] + v[i][1] * v[i][1] + v[i][2] * v[i][2] + v[i][3] * v[i][3];
    return wsum(s); }
__device__ __forceinline__ void ph_h0(const Params& p, int wave, int lane) {
    const int nw = gridDim.x * 8, gw = blockIdx.x * 8 + wave;
    const float* g = p.in[6];
    const float* mod = (const float*)(p.ws + WS_MOD);
    bf16_t* H = (bf16_t*)(p.ws + WS_BIG + L0_ACT);
    {
        const int r_lo = (int)((long long)gw * TT / nw), r_hi = (int)((long long)(gw + 1) * TT / nw);
        int mr = -1;
        f32x4 gv[4], shv[4], scv[4];
#pragma unroll
        for (int i = 0; i < 4; ++i) { const int c = 4 * lane + 256 * i; gv[i] = ld4(g + c); shv[i] = gv[i]; scv[i] = gv[i]; }
        for (int row = r_lo; row < r_hi; ++row) {
            if (mod_row(row) != mr) { mr = mod_row(row);
#pragma unroll
                for (int i = 0; i < 4; ++i) { const int c = 4 * lane + 256 * i; shv[i] = ld4(mod + mr * 6144 + c); scv[i] = ld4(mod + mr * 6144 + 1024 + c); } }
            const float* src = row < TCTX ? p.in[2] + (size_t)row * DM : p.in[0] + (size_t)(row - TCTX) * DM;
            f32x4 v[4];
#pragma unroll
            for (int i = 0; i < 4; ++i) v[i] = ld4(src + 4 * lane + 256 * i);
            const float rs = rsqrtf(row_ss(v) * (1.0f / DM) + EPS);
#pragma unroll
            for (int i = 0; i < 4; ++i) stbf4(H + (size_t)row * DM + 4 * lane + 256 * i, v[i] * rs * gv[i] * (1.0f + scv[i]) + shv[i]);
        }
    }
}

__device__ __forceinline__ int dma_row(int piece, int lane) { return piece * 16 + (lane >> 2); }
__device__ __forceinline__ int dma_chunk(int lane) { return (lane & 3) ^ ((lane >> 4) & 3); }
template <int NJ>
__device__ __forceinline__ void gemm_issue(LAS uchar* stage, const uchar* const (&ap)[2], const uchar* const (&bp)[NJ / 2], int kbyte, int wave) {
#pragma unroll
    for (int i = 0; i < 2; ++i) dma16(ap[i] + kbyte, stage + (wave * 2 + i) * 1024);
#pragma unroll
    for (int i = 0; i < NJ / 2; ++i) dma16(bp[i] + kbyte, stage + 16384 + (wave * (NJ / 2) + i) * 1024);
}
#define VMWAIT(n) asm volatile("s_waitcnt vmcnt(" #n ")" ::: "memory")
#define VLWAIT(n) asm volatile("s_waitcnt vmcnt(" #n ") lgkmcnt(0)" ::: "memory")
#define BAR_RAW() do { asm volatile("" ::: "memory"); __builtin_amdgcn_s_barrier(); asm volatile("" ::: "memory"); } while (0)
template <int NJ>
__device__ __forceinline__ void gemm_run(LAS uchar* lds, const uchar* const (&ap)[2], const uchar* const (&bp)[NJ / 2], int nkt, f32x16 (&acc)[NJ][2], int wave, int lane) {
    constexpr int STAGE = (256 + NJ * 64) * 64;
    const int r32 = lane & 31, h = lane >> 5, wm = wave >> 1, wn = wave & 1, sw = (r32 >> 2) & 3;
    const int a_base = (wm * 64 + r32) * 64, b_base = 16384 + (wn * NJ * 32 + r32) * 64;
    const int c0 = (h ^ sw) << 4, c1 = ((2 + h) ^ sw) << 4;
    const bool upper = wave >= 4;
    gemm_issue<NJ>(lds, ap, bp, 0, wave);
    gemm_issue<NJ>(lds + STAGE, ap, bp, 64, wave);
    gemm_issue<NJ>(lds + 2 * STAGE, ap, bp, 128, wave);
    if (NJ == 4) VMWAIT(8); else VMWAIT(6);
    if (upper) BAR_RAW();
    for (int kt = 0; kt < nkt; ++kt) {
        BAR_RAW();
        if (kt + 3 < nkt) gemm_issue<NJ>(lds + ((kt + 3) & 3) * STAGE, ap, bp, (kt + 3) * 64, wave);
        const LAS uchar* st = lds + (kt & 3) * STAGE;
        bf16x8 a[2][2], b[2][NJ];
#pragma unroll
        for (int ks = 0; ks < 2; ++ks) {
            const int co = ks ? c1 : c0;
            a[ks][0] = *(const LAS bf16x8*)(st + a_base + co); a[ks][1] = *(const LAS bf16x8*)(st + a_base + 2048 + co);
#pragma unroll
            for (int jn = 0; jn < NJ; ++jn) b[ks][jn] = *(const LAS bf16x8*)(st + b_base + jn * 2048 + co);
        }
        if (kt + 3 < nkt) { if (NJ == 4) VLWAIT(8); else VLWAIT(6); }
        else if (kt + 2 < nkt) { if (NJ == 4) VLWAIT(4); else VLWAIT(3); }
        else VLWAIT(0);
        __builtin_amdgcn_sched_barrier(0);
        BAR_RAW();
        __builtin_amdgcn_sched_barrier(0);
        __builtin_amdgcn_s_setprio(1);
#pragma unroll
        for (int ks = 0; ks < 2; ++ks)
#pragma unroll
            for (int jn = 0; jn < NJ; ++jn) { acc[jn][0] = MFMA32(b[ks][jn], a[ks][0], acc[jn][0]); acc[jn][1] = MFMA32(b[ks][jn], a[ks][1], acc[jn][1]); }
        __builtin_amdgcn_s_setprio(0);
        __builtin_amdgcn_sched_barrier(0);
    }
    if (!upper) BAR_RAW();
}
__device__ __forceinline__ int dma64_row(int piece, int lane) { return piece * 8 + (lane >> 3); }
__device__ __forceinline__ int dma64_chunk(int piece, int lane) { return (lane & 7) ^ ((piece * 4 + (lane >> 4)) & 7); }
template <int NJ>
__device__ __forceinline__ void dense64_ptrs(const bf16_t* A, const bf16_t* Bt, int K, int m0, int n0, const uchar* (&ap)[4], const uchar* (&bp)[NJ], int wave, int lane) {
#pragma unroll
    for (int i = 0; i < 4; ++i) { const int pc = wave * 4 + i; ap[i] = (const uchar*)(A + (size_t)(m0 + dma64_row(pc, lane)) * K) + dma64_chunk(pc, lane) * 16; }
#pragma unroll
    for (int i = 0; i < NJ; ++i) { const int pc = wave * NJ + i; bp[i] = (const uchar*)(Bt + (size_t)(n0 + dma64_row(pc, lane)) * K) + dma64_chunk(pc, lane) * 16; }
}
template <int NJ, bool DB = true>
__device__ __forceinline__ void gemm64_run(LAS uchar* lds, const uchar* const (&ap)[4], const uchar* const (&bp)[NJ], int nkt, f32x16 (&acc)[NJ][2], int wave, int lane) {
    constexpr int STAGE = (256 + NJ * 64) * 128;
    const int r32 = lane & 31, h = lane >> 5, wm = wave >> 1, wn = wave & 1;
    const int a_base = (wm * 64 + r32) * 128, b_base = 32768 + (wn * NJ * 32 + r32) * 128, cx = (h ^ ((r32 >> 1) & 7)) << 4;
#pragma unroll
    for (int i = 0; i < 4; ++i) dma16(ap[i], lds + (wave * 4 + i) * 1024);
#pragma unroll
    for (int i = 0; i < NJ; ++i) dma16(bp[i], lds + 32768 + (wave * NJ + i) * 1024);
    for (int kt = 0; kt < nkt; ++kt) {
        VMWAIT(0);
        BAR_RAW();
        const LAS uchar* st = lds + (kt & 1) * STAGE;
        LAS uchar* sn = lds + ((kt + 1) & 1) * STAGE;
        const int kb = (kt + 1) * 128;
        const bool more = kt + 1 < nkt;
        bf16x8 fa[2][2], fb[2][NJ];
#define LDFRAG(set_, ks_) do { const int co_ = cx ^ ((ks_) << 5); \
            fa[set_][0] = *(const LAS bf16x8*)(st + a_base + co_); fa[set_][1] = *(const LAS bf16x8*)(st + a_base + 4096 + co_); \
            _Pragma("unroll") for (int jn = 0; jn < NJ; ++jn) fb[set_][jn] = *(const LAS bf16x8*)(st + b_base + jn * 4096 + co_); } while (0)
        LDFRAG(0, 0);
#pragma unroll
        for (int ks = 0; ks < 4; ++ks) {
            if (more) {
                if (ks < 2) { dma16(ap[2 * ks] + kb, sn + (wave * 4 + 2 * ks) * 1024); dma16(ap[2 * ks + 1] + kb, sn + (wave * 4 + 2 * ks + 1) * 1024); }
                else {
#pragma unroll
                    for (int i = (ks - 2) * (NJ / 2); i < (ks - 1) * (NJ / 2); ++i) dma16(bp[i] + kb, sn + 32768 + (wave * NJ + i) * 1024);
                }
            }
            if (DB) { if (ks < 3) LDFRAG((ks + 1) & 1, ks + 1); } else { if (ks > 0) LDFRAG(ks & 1, ks); }
            __builtin_amdgcn_sched_barrier(0);
            __builtin_amdgcn_s_setprio(1);
#pragma unroll
            for (int jn = 0; jn < NJ; ++jn) { acc[jn][0] = MFMA32(fb[ks & 1][jn], fa[ks & 1][0], acc[jn][0]); acc[jn][1] = MFMA32(fb[ks & 1][jn], fa[ks & 1][1], acc[jn][1]); }
            __builtin_amdgcn_s_setprio(0);
            __builtin_amdgcn_sched_barrier(0);
        }
#undef LDFRAG
    }
}
template <int NJ> __device__ __forceinline__ void zero_acc(f32x16 (&acc)[NJ][2]) {
#pragma unroll
    for (int a = 0; a < NJ; ++a)
#pragma unroll
        for (int b = 0; b < 2; ++b)
#pragma unroll
            for (int r = 0; r < 16; ++r) acc[a][b][r] = 0.f;
}
template <int NJ>
__device__ __forceinline__ void dense_ptrs(const bf16_t* A, const bf16_t* Bt, int K, int m0, int n0, const uchar* (&ap)[2], const uchar* (&bp)[NJ / 2], int wave, int lane) {
#pragma unroll
    for (int i = 0; i < 2; ++i) ap[i] = (const uchar*)(A + (size_t)(m0 + dma_row(wave * 2 + i, lane)) * K) + dma_chunk(lane) * 16;
#pragma unroll
    for (int i = 0; i < NJ / 2; ++i) bp[i] = (const uchar*)(Bt + (size_t)(n0 + dma_row(wave * (NJ / 2) + i, lane)) * K) + dma_chunk(lane) * 16;
}
__device__ __forceinline__ void tok_pos(int row, int& b, int& pos) {
    if (row < TCTX) { b = row >> 8; pos = row & 255; } else { b = (row - TCTX) >> 12; pos = LCTX + ((row - TCTX) & 4095); } }
__device__ __forceinline__ void rope_head(f32x16 (&v)[2], int row, int h, const float* ct, const float* st) {
    const int t = (row - TCTX) & 4095;
#pragma unroll
    for (int jn = 0; jn < 2; ++jn) {
        const int pc = (jn == 0) ? (t >> 6) : (t & 63);
#pragma unroll
        for (int rq = 0; rq < 4; ++rq) {
            const f32x2 c = *(const f32x2*)(ct + pc * 16 + 4 * rq + 2 * h), s = *(const f32x2*)(st + pc * 16 + 4 * rq + 2 * h);
            const float x1 = v[jn][4 * rq], x2 = v[jn][4 * rq + 1], y1 = v[jn][4 * rq + 2], y2 = v[jn][4 * rq + 3];
            v[jn][4 * rq] = x1 * c.x - x2 * s.x; v[jn][4 * rq + 1] = x1 * s.x + x2 * c.x;
            v[jn][4 * rq + 2] = y1 * c.y - y2 * s.y; v[jn][4 * rq + 3] = y1 * s.y + y2 * c.y;
        }
    }
}
__device__ __forceinline__ void store_blk32(bf16_t* dst, const f32x16& v, int h) {
#pragma unroll
    for (int pr = 0; pr < 2; ++pr) {
        const unsigned ax = cvt_pk(v[8 * pr], v[8 * pr + 1]), ay = cvt_pk(v[8 * pr + 2], v[8 * pr + 3]);
        const unsigned bx = cvt_pk(v[8 * pr + 4], v[8 * pr + 5]), by = cvt_pk(v[8 * pr + 6], v[8 * pr + 7]);
        const auto rx = __builtin_amdgcn_permlane32_swap(ax, bx, false, false);
        const auto ry = __builtin_amdgcn_permlane32_swap(ay, by, false, false);
        u32x4 w; w.x = rx[0]; w.y = ry[0]; w.z = rx[1]; w.w = ry[1];
        *(u32x4*)(dst + 16 * pr + 8 * h) = w;
    }
}
__device__ __forceinline__ void store_head8(uchar* dst, const f32x16 (&v)[2], int h, float qs) {
#pragma unroll
    for (int jn = 0; jn < 2; ++jn) {
        unsigned q4[4];
#pragma unroll
        for (int rq = 0; rq < 4; ++rq) q4[rq] = pk_fp8x4(v[jn][4 * rq] * qs, v[jn][4 * rq + 1] * qs, v[jn][4 * rq + 2] * qs, v[jn][4 * rq + 3] * qs);
        const auto ra = __builtin_amdgcn_permlane32_swap(q4[0], q4[2], false, false);
        const auto rb = __builtin_amdgcn_permlane32_swap(q4[1], q4[3], false, false);
        u32x4 q; q.x = ra[0]; q.y = ra[1]; q.z = rb[0]; q.w = rb[1];
        *(u32x4*)(dst + jn * 32 + 16 * h) = q;
    }
}
__device__ __forceinline__ void vt_scatter(LAS uchar* lt, const f32x16 (&v)[2], int im, int r32, int h) {
    const int j = 32 * ((r32 >> 2) & 1) + 16 * im + (r32 & 3) + 4 * (r32 >> 3);
    LAS uchar* base = lt + (4 * h) * 64 + j;
#pragma unroll
    for (int jn = 0; jn < 2; ++jn)
#pragma unroll
        for (int rq = 0; rq < 4; ++rq) {
            const unsigned w = pk_fp8x4(v[jn][4 * rq] * V_QS, v[jn][4 * rq + 1] * V_QS, v[jn][4 * rq + 2] * V_QS, v[jn][4 * rq + 3] * V_QS);
#pragma unroll
            for (int i = 0; i < 4; ++i) base[(jn * 32 + i + 8 * rq) * 64] = (uchar)(w >> (8 * i));
        }
}
__device__ __forceinline__ void store_head(bf16_t* dst, const f32x16 (&v)[2], int h) {
    store_blk32(dst, v[0], h); store_blk32(dst + 32, v[1], h);
}

#define DENSE_UNITS(mt_, nt_, mt_lo_, nM_, nN_) \
    for (int q_ = (int)blockIdx.x >> 3, mt_ = (mt_lo_) + ((int)blockIdx.x & 7) + 8 * (q_ / (nN_)), nt_ = q_ % (nN_); mt_ < (nM_); \
         q_ += (int)gridDim.x >> 3, mt_ = (mt_lo_) + ((int)blockIdx.x & 7) + 8 * (q_ / (nN_)), nt_ = q_ % (nN_))
__device__ __forceinline__ void ph_inproj0(const Params& p, LAS uchar* lds, int wave, int lane) {
    const bf16_t* A = (const bf16_t*)(p.ws + WS_BIG + L0_ACT);
    const bf16_t* Bt = (const bf16_t*)(p.ws + WS_WD + WD_ABIN);
    const float* ct = (const float*)(p.ws + WS_ROPE); const float* st = ct + 1024;
    uchar* big = p.ws + WS_BIG;
    const int r32 = lane & 31, h = lane >> 5, wm = wave >> 1, wn = wave & 1;
    DENSE_UNITS(mt, nt, 0, 68, 6) {
        const uchar* ap[4]; const uchar* bp[4];
        dense64_ptrs<4>(A, Bt, 1024, mt * 256, nt * 256, ap, bp, wave, lane);
        f32x16 acc[4][2]; zero_acc<4>(acc);
        gemm64_run<4, false>(lds, ap, bp, 16, acc, wave, lane);
#pragma unroll
        for (int hh = 0; hh < 2; ++hh) {
            const int hs = nt * 4 + wn * 2 + hh;
            const bool is_norm = hs < 10, is_rope = (hs < 10) || (hs >= 12 && hs < 22), is_q = (hs < 8) || (hs >= 12 && hs < 20);
            f32x16 gn[2];
            if (is_norm) { const float* g = p.in[hs < 8 ? 9 : 10];
#pragma unroll
                for (int jn = 0; jn < 2; ++jn)
#pragma unroll
                    for (int rq = 0; rq < 4; ++rq) { const f32x4 t = ld4(g + jn * 32 + 8 * rq + 4 * h); gn[jn][4 * rq] = t[0]; gn[jn][4 * rq + 1] = t[1]; gn[jn][4 * rq + 2] = t[2]; gn[jn][4 * rq + 3] = t[3]; } }
#pragma unroll
            for (int im = 0; im < 2; ++im) {
                const int row = mt * 256 + wm * 64 + im * 32 + r32;
                f32x16 v[2] = {acc[2 * hh][im], acc[2 * hh + 1][im]};
                if (is_norm) {
                    float ss = 0.f;
#pragma unroll
                    for (int r = 0; r < 16; ++r) ss += v[0][r] * v[0][r] + v[1][r] * v[1][r];
                    ss += __shfl_xor(ss, 32);
                    const float rs = rsqrtf(ss * (1.0f / 64.0f) + EPS);
#pragma unroll
                    for (int r = 0; r < 16; ++r) { v[0][r] = v[0][r] * rs * gn[0][r]; v[1][r] = v[1][r] * rs * gn[1][r]; }
                }
                if (is_rope && row >= TCTX) rope_head(v, row, h, ct, st);
                if (is_q) {
#pragma unroll
                    for (int r = 0; r < 16; ++r) { v[0][r] *= QSCALE; v[1][r] *= QSCALE; } }
                int b, pos; tok_pos(row, b, pos);
                if (hs < 8) store_head8(big + L0_QA + (size_t)row * 512 + hs * 64, v, h, Q_QS);
                else if (hs < 10) store_head8(big + L0_KA + ((size_t)(b * 2 + hs - 8) * NPOS + pos) * 64, v, h, K_QS);
                else if (hs < 12) vt_scatter(lds + hh * 16384 + wm * 4096, v, im, r32, h);
                else if (hs < 20) store_head8(big + L0_QB + (size_t)row * 512 + (hs - 12) * 64, v, h, Q_QS);
                else if (hs < 22) store_head8(big + L0_KB + ((size_t)(b * 2 + hs - 20) * NPOS + pos) * 64, v, h, K_QS);
                else vt_scatter(lds + hh * 16384 + wm * 4096, v, im, r32, h);
            }
        }
        if (nt == 2 || nt == 5) {
            asm volatile("s_waitcnt lgkmcnt(0)" ::: "memory"); BAR_RAW();
            int b0, pos0; tok_pos(mt * 256, b0, pos0);
            uchar* vt = big + (nt == 2 ? L0_VA : L0_VB);
#pragma unroll
            for (int i = 0; i < 4; ++i) { const int ca = (int)threadIdx.x + 512 * i, sidx = ca >> 10, c = ca & 1023;
                const u32x4 w = *(const LAS u32x4*)(lds + sidx * 16384 + c * 16);
                *(u32x4*)(vt + (size_t)(b0 * 2 + sidx) * NPOS * 64 + (size_t)(pos0 >> 6) * 4096 + c * 16) = w; }
            __syncthreads();
        }
    }
    if (gridDim.x == 256) {
        const int x = blockIdx.x & 7, r = blockIdx.x >> 3; int ib = -1;
        if (x < 4) { if (r >= 22) ib = x * 10 + (r - 22); } else { if (r >= 16) ib = 40 + (x - 4) * 16 + (r - 16); }
        if (ib >= 0) conv_strided(p, 0, 0, ib * 8 + wave, 832, 4, CV_A0, lane);
    }
}
template <int NJ>
__device__ __forceinline__ void inproj1_unit(const Params& p, LAS uchar* lds, int wave, int lane, int mt, int nt) {
    constexpr int SL = NJ / 2;
    const bf16_t* A = (const bf16_t*)(p.ws + WS_BIG + L1_H);
    const bf16_t* Bt = (const bf16_t*)(p.ws + WS_WD + WD_CIN);
    const float* ct = (const float*)(p.ws + WS_ROPE); const float* st = ct + 1024;
    uchar* big = p.ws + WS_BIG;
    const int r32 = lane & 31, h = lane >> 5, wm = wave >> 1, wn = wave & 1;
    const uchar* ap[4]; const uchar* bp[NJ];
    dense64_ptrs<NJ>(A, Bt, 1024, mt * 256, nt * NJ * 64, ap, bp, wave, lane);
    f32x16 acc[NJ][2]; zero_acc<NJ>(acc);
    gemm64_run<NJ>(lds, ap, bp, 16, acc, wave, lane);
#pragma unroll
    for (int hh = 0; hh < SL; ++hh) {
        const int hs = nt * NJ + wn * SL + hh;
#pragma unroll
        for (int im = 0; im < 2; ++im) {
            const int row = mt * 256 + wm * 64 + im * 32 + r32;
            f32x16 v[2] = {acc[2 * hh][im], acc[2 * hh + 1][im]};
            if (hs < 32 && row >= TCTX) rope_head(v, row, h, ct, st);
            if (hs < 16) {
#pragma unroll
                for (int r = 0; r < 16; ++r) { v[0][r] *= QSCALE; v[1][r] *= QSCALE; } }
            int b, pos; tok_pos(row, b, pos);
            if (hs < 16) store_head8(big + L1_QC + (size_t)row * 1024 + hs * 64, v, h, Q_QS);
            else if (hs < 32) store_head8(big + L1_KC + ((size_t)(b * 16 + hs - 16) * NPOS + pos) * 64, v, h, K_QS);
            else vt_scatter(lds + (wn * SL + hh) * 16384 + wm * 4096, v, im, r32, h);
        }
    }
    if (nt * NJ >= 32) {
        asm volatile("s_waitcnt lgkmcnt(0)" ::: "memory"); BAR_RAW();
        int b0, pos0; tok_pos(mt * 256, b0, pos0);
#pragma unroll
        for (int i = 0; i < 2 * NJ; ++i) { const int ca = (int)threadIdx.x + 512 * i, sidx = ca >> 10, c = ca & 1023;
            const int hv = nt * NJ + sidx - 32, head = hv >> 1, half = hv & 1;
            const u32x4 w = *(const LAS u32x4*)(lds + sidx * 16384 + c * 16);
            *(u32x4*)(big + L1_VC + (size_t)(b0 * 8 + head) * NPOS * 128 + (size_t)((pos0 >> 6) + (c >> 8)) * 8192 + half * 4096 + (c & 255) * 16) = w; }
        __syncthreads();
    }
}
__device__ __forceinline__ void ph_inproj1(const Params& p, LAS uchar* lds, int wave, int lane) {
    DENSE_UNITS(mt, nt, 0, 64, 12) inproj1_unit<4>(p, lds, wave, lane, mt, nt);
    for (int u = blockIdx.x; u < 96; u += gridDim.x) inproj1_unit<2>(p, lds, wave, lane, 64 + (u & 3), u >> 2);
    if (gridDim.x == 256 && blockIdx.x >= 96) conv_strided(p, 1, 0, ((int)blockIdx.x - 96) * 8 + wave, 1280, 2, CV_A1, lane);
}
template <int NJ>
__device__ __forceinline__ void ph_outproj(const Params& p, LAS uchar* lds, int wave, int lane, const bf16_t* A, const bf16_t* Bt, bf16_t* PO, int mt_lo) {
    constexpr int NTN = 1024 / (NJ * 64);
    const int r32 = lane & 31, h = lane >> 5, wm = wave >> 1, wn = wave & 1;
    DENSE_UNITS(mt, nt, mt_lo, 68, NTN) {
        const uchar* ap[4]; const uchar* bp[NJ];
        dense64_ptrs<NJ>(A, Bt, 1024, mt * 256, nt * NJ * 64, ap, bp, wave, lane);
        f32x16 acc[NJ][2]; zero_acc<NJ>(acc);
        gemm64_run<NJ>(lds, ap, bp, 16, acc, wave, lane);
#pragma unroll
        for (int im = 0; im < 2; ++im) {
            const int row = mt * 256 + wm * 64 + im * 32 + r32;
#pragma unroll
            for (int jn = 0; jn < NJ; ++jn) store_blk32(PO + (size_t)row * 1024 + nt * NJ * 64 + wn * NJ * 32 + jn * 32, acc[jn][im], h);
        }
    }
    if (NJ == 2 && mt_lo == 0 && gridDim.x == 256) {
        const int x = blockIdx.x & 7, r = blockIdx.x >> 3; int jb = -1;
        if (x < 4) { if (r >= 8) jb = x * 24 + (r - 8); } else jb = 96 + (x - 4) * 32 + r;
        if (jb >= 0) conv_strided(p, 0, CV_A0, jb * 8 + wave, 1792, 1, CV_B0, lane);
    }
}

template <int DV> __device__ __forceinline__ void attn_issue(LAS uchar* st, const uchar* k0p, const uchar* k1p, const uchar* vp0, const uchar* vp1, int tpos, bool two_k, int wave) {
    if (wave < 4) dma16(k0p + (size_t)tpos * 4096, st + wave * 1024);
    else if (two_k) dma16(k1p + (size_t)tpos * 4096, st + 4096 + (wave - 4) * 1024);
    if (DV == 64) { if (wave >= 4) dma16(vp0 + (size_t)tpos * 4096, st + 8192 + (wave - 4) * 1024); }
    else dma16(vp0 + (size_t)tpos * 8192, st + 8192 + wave * 1024);
}
struct AttnUnit {
    const uchar *q0, *q1;
    int qstride;
    const uchar *k0, *k1;
    const uchar* v;
    int t0b, t0e, t1b, t1e;
    int qlat0;
    float sink0, sink1;
    bf16_t *o0, *o1;
    int ostride;
};
template <int DV, int MODE, int AF = 0>
__device__ __forceinline__ void attn_unit(const Params& p, LAS uchar* lds, const AttnUnit& U, int wave, int lane) {
    constexpr int DVB = DV / 32;
    const int r32 = lane & 31, h = lane >> 5, s = wave >> 2, qs = wave & 3;
    const int krow = (wave & 3) * 16 + (lane >> 2);
    const uchar* k0p = U.k0 + krow * 64 + dma_chunk(lane) * 16;
    const uchar* k1p = U.k1 + krow * 64 + dma_chunk(lane) * 16;
    const uchar* vp0 = U.v + (((DV == 64) ? (wave & 3) : wave) * 16 + (lane >> 2)) * 64 + dma_chunk(lane) * 16;
    const uchar* vp1 = vp0;
    const int n0 = U.t0e - U.t0b, nt = n0 + (U.t1e - U.t1b);
    i32x8 qf;
    { const uchar* qp = (s ? U.q1 : U.q0) + (size_t)(qs * 32 + r32) * U.qstride + 32 * h;
      const i32x4 lo_ = *(const i32x4*)qp, hi_ = *(const i32x4*)(qp + 16);
      qf = __builtin_shufflevector(lo_, hi_, 0, 1, 2, 3, 4, 5, 6, 7); }
    f32x16 O[DVB];
#pragma unroll
    for (int d = 0; d < DVB; ++d)
#pragma unroll
        for (int r = 0; r < 16; ++r) O[d][r] = 0.f;
    float m = -1e30f, l = 0.f;
    const int qlat = U.qlat0 + qs * 32 + r32, qw0 = U.qlat0 + qs * 32;
    const int kbase = r32 * 64, kc0 = ((2 * h) ^ ((r32 >> 2) & 3)) << 4, kc1 = ((2 * h + 1) ^ ((r32 >> 2) & 3)) << 4;
#define TILE_POS(jj) (((jj) < n0) ? U.t0b + (jj) : U.t1b + ((jj) - n0))
#define PV_TILE(stp) do { const LAS uchar* Vl_ = (stp) + 8192 + kbase; \
        _Pragma("unroll") for (int d = 0; d < DVB; ++d) { \
            const i32x4 a_ = *(const LAS i32x4*)(Vl_ + d * 2048 + kc0), b_ = *(const LAS i32x4*)(Vl_ + d * 2048 + kc1); \
            const i32x8 vf = __builtin_shufflevector(a_, b_, 0, 1, 2, 3, 4, 5, 6, 7); \
            O[d] = __builtin_amdgcn_mfma_scale_f32_32x32x64_f8f6f4(vf, pq, O[d], 0, 0, 0, V_E8M0, 0, P_E8M0); } } while (0)
    attn_issue<DV>(lds, k0p, k1p, vp0, vp1, TILE_POS(0), MODE == 2, wave);
    if (nt > 1) attn_issue<DV>(lds + 32768, k0p, k1p, vp0, vp1, TILE_POS(1), MODE == 2, wave);
    asm volatile("" :: "v"(qf));
    f32x16 cinit;
#pragma unroll
    for (int r = 0; r < 16; ++r) cinit[r] = P_OFF;
    asm volatile("" : "+v"(cinit));
    i32x8 pq; bool have = false; const LAS uchar* pst = lds;
    for (int j = 0; j < nt; ++j) {
        if (!(AF & 8)) { if (j + 1 < nt) { if (MODE == 2) VMWAIT(2); else VMWAIT(1); } else VMWAIT(0);
        BAR_RAW(); }
        const LAS uchar* st = lds + (j & 3) * 32768;
        if (j + 2 < nt && !(AF & 8)) attn_issue<DV>(lds + ((j + 2) & 3) * 32768, k0p, k1p, vp0, vp1, TILE_POS(j + 2), MODE == 2, wave);
        const int tp = TILE_POS(j);
        const int kl0 = tp * 64 - LCTX;
        bool skip = false;
        if (MODE == 1 && kl0 >= 0) skip = (kl0 > qw0 + 31 + 128) || (kl0 + 63 < qw0 - 128);
        f32x16 S0, S1;
        if (!skip) {
            const LAS uchar* Kl = st + ((MODE == 2) ? s * 4096 : 0);
            if (!(AF & 4)) {
            { i32x8 kf0, kf1;
              { const i32x4 a_ = *(const LAS i32x4*)(Kl + kbase + kc0), b_ = *(const LAS i32x4*)(Kl + kbase + kc1); kf0 = __builtin_shufflevector(a_, b_, 0, 1, 2, 3, 4, 5, 6, 7); }
              { const i32x4 a_ = *(const LAS i32x4*)(Kl + kbase + 2048 + kc0), b_ = *(const LAS i32x4*)(Kl + kbase + 2048 + kc1); kf1 = __builtin_shufflevector(a_, b_, 0, 1, 2, 3, 4, 5, 6, 7); }
              S0 = __builtin_amdgcn_mfma_scale_f32_32x32x64_f8f6f4(kf0, qf, cinit, 0, 0, 0, K_E8M0, 0, Q_E8M0);
              S1 = __builtin_amdgcn_mfma_scale_f32_32x32x64_f8f6f4(kf1, qf, cinit, 0, 0, 0, K_E8M0, 0, Q_E8M0); }
            } else { asm volatile("" : "+v"(S0), "+v"(S1)); }
        }
        if (have && !(AF & 2)) PV_TILE(pst);
        if (!skip) {
            if (MODE == 1 && kl0 >= 0) {
#pragma unroll
                for (int r = 0; r < 16; ++r) {
                    const int d0 = qlat - (kl0 + crow(r, h)), d1 = d0 - 32;
                    if (d0 > 128 || d0 < -128) S0[r] = -1e30f;
                    if (d1 > 128 || d1 < -128) S1[r] = -1e30f;
                }
            }
            if (j == 0) {
                float mx = fmaxf(S0[0], S1[0]);
#pragma unroll
                for (int r = 1; r < 16; ++r) mx = fmaxf(mx, fmaxf(S0[r], S1[r]));
                { const auto rr_ = __builtin_amdgcn_permlane32_swap(__float_as_uint(mx), __float_as_uint(mx), false, false); mx = fmaxf(__uint_as_float(rr_[0]), __uint_as_float(rr_[1])); }
                m = mx - P_OFF;
                float ls = 0.f;
#pragma unroll
                for (int r = 0; r < 16; ++r) { S0[r] = __builtin_amdgcn_exp2f(S0[r] - m); S1[r] = __builtin_amdgcn_exp2f(S1[r] - m); ls += S0[r] + S1[r]; }
                l = ls;
#pragma unroll
                for (int r = 0; r < 16; ++r) cinit[r] = P_OFF - m;
                asm volatile("" : "+v"(cinit));
            } else {
                float tm;
                asm volatile("s_nop 15\n\tv_max3_f32 %0, %1, %2, %3" : "=v"(tm) : "v"(S0[0]), "v"(S1[0]), "v"(S0[1]));
#pragma unroll
                for (int r = 1; r < 15; ++r) asm("v_max3_f32 %0, %1, %2, %3" : "=v"(tm) : "v"(tm), "v"(S1[r]), "v"(S0[r + 1]));
                asm("v_max_f32 %0, %1, %2" : "=v"(tm) : "v"(tm), "v"(S1[15]));
                { const auto rr_ = __builtin_amdgcn_permlane32_swap(__float_as_uint(tm), __float_as_uint(tm), false, false); tm = fmaxf(__uint_as_float(rr_[0]), __uint_as_float(rr_[1])); }
                if (__any(tm > ATT_THR + P_OFF)) {
                    const float dlt = tm > ATT_THR + P_OFF ? tm - P_OFF : 0.f, alpha = __builtin_amdgcn_exp2f(-dlt);
                    m += dlt; l *= alpha;
#pragma unroll
                    for (int r = 0; r < 16; ++r) { S0[r] -= dlt; S1[r] -= dlt; cinit[r] = P_OFF - m; }
                    asm volatile("" : "+v"(cinit));
#pragma unroll
                    for (int d = 0; d < DVB; ++d)
#pragma unroll
                        for (int r = 0; r < 16; ++r) O[d][r] *= alpha;
                }
                float ls = 0.f;
#pragma unroll
                for (int r = 0; r < 16; ++r) { S0[r] = __builtin_amdgcn_exp2f(S0[r]); S1[r] = __builtin_amdgcn_exp2f(S1[r]); ls += S0[r] + S1[r]; }
                l += ls;
            }
            pq[0] = (int)pk_fp8x4_nc(S0[0], S0[1], S0[2], S0[3]);       pq[1] = (int)pk_fp8x4_nc(S0[4], S0[5], S0[6], S0[7]);
            pq[2] = (int)pk_fp8x4_nc(S0[8], S0[9], S0[10], S0[11]);     pq[3] = (int)pk_fp8x4_nc(S0[12], S0[13], S0[14], S0[15]);
            pq[4] = (int)pk_fp8x4_nc(S1[0], S1[1], S1[2], S1[3]);       pq[5] = (int)pk_fp8x4_nc(S1[4], S1[5], S1[6], S1[7]);
            pq[6] = (int)pk_fp8x4_nc(S1[8], S1[9], S1[10], S1[11]);     pq[7] = (int)pk_fp8x4_nc(S1[12], S1[13], S1[14], S1[15]);
            have = true; pst = st;
        } else have = false;
    }
    if (have && !(AF & 2)) PV_TILE(pst);
#undef PV_TILE
    float lt = l + __shfl_xor(l, 32);
    if (MODE == 1) lt += __builtin_amdgcn_exp2f((s ? U.sink1 : U.sink0) - m + P_OFF);
    const float inv = P_QS / lt;
#pragma unroll
    for (int d = 0; d < DVB; ++d)
#pragma unroll
        for (int r = 0; r < 16; ++r) O[d][r] *= inv;
    if (MODE != 2) {
        bf16_t* op = (s ? U.o1 : U.o0) + (size_t)(qs * 32 + r32) * U.ostride;
#pragma unroll
        for (int d = 0; d < DVB; ++d)
#pragma unroll
            for (int rq = 0; rq < 4; ++rq) stbf4(op + d * 32 + 8 * rq + 4 * h, (f32x4){O[d][4 * rq], O[d][4 * rq + 1], O[d][4 * rq + 2], O[d][4 * rq + 3]});
        __syncthreads();
    } else {
        __syncthreads();
        LAS float* X = (LAS float*)lds + (size_t)qs * DVB * 16 * 64 + lane;
        if (s == 1) {
#pragma unroll
            for (int d = 0; d < DVB; ++d)
#pragma unroll
                for (int r = 0; r < 16; ++r) X[(d * 16 + r) * 64] = O[d][r];
        }
        __syncthreads();
        if (s == 0) {
            const float lam = *(const float*)(p.ws + WS_LAM);
            float ss = 0.f;
#pragma unroll
            for (int d = 0; d < DVB; ++d)
#pragma unroll
                for (int r = 0; r < 16; ++r) { const float o = O[d][r] - lam * X[(d * 16 + r) * 64]; O[d][r] = o; ss += o * o; }
            ss += __shfl_xor(ss, 32);
            const float rs = rsqrtf(ss * (1.0f / 128.0f) + EPS) * (1.0f - LAMBDA_INIT);
            const float* sg = p.in[15];
            bf16_t* op = U.o0 + (size_t)(qs * 32 + r32) * U.ostride;
#pragma unroll
            for (int d = 0; d < DVB; ++d)
#pragma unroll
                for (int rq = 0; rq < 4; ++rq) { const f32x4 g = ld4(sg + d * 32 + 8 * rq + 4 * h);
                    stbf4(op + d * 32 + 8 * rq + 4 * h, (f32x4){O[d][4 * rq] * rs * g[0], O[d][4 * rq + 1] * rs * g[1], O[d][4 * rq + 2] * rs * g[2], O[d][4 * rq + 3] * rs * g[3]}); }
        }
        __syncthreads();
    }
}
__device__ __forceinline__ void ph_attn0(const Params& p, LAS uchar* lds, int wave, int lane) {
    uchar* big = p.ws + WS_BIG;
    const uchar *QA = big + L0_QA, *QB = big + L0_QB, *KA = big + L0_KA, *KB = big + L0_KB, *VA = big + L0_VA, *VB = big + L0_VB;
    bf16_t* Oo = (bf16_t*)(big + L0_ACT);
    const float* sink = p.in[11];
    int cdone = 0; const int crounds = (CONV_T - conv_base(0) + (int)gridDim.x * 8 - 1) / ((int)gridDim.x * 8);
    for (int u = blockIdx.x; u < 512; u += gridDim.x) {
        const int xq = u & 7, iq = u >> 3, b = xq >> 1, kvh = xq & 1, pr = iq >> 5, qt = iq & 31, hd = kvh * 4 + pr * 2;
        const size_t row0 = (size_t)TCTX + (size_t)b * SEQ + qt * 128;
        AttnUnit U; U.qstride = 512; U.ostride = 1024;
        U.q0 = QA + row0 * 512 + hd * 64; U.q1 = U.q0 + 64;
        U.k0 = U.k1 = KA + (size_t)(b * 2 + kvh) * NPOS * 64; U.v = VA + (size_t)(b * 2 + kvh) * NPOS * 64;
        U.t0b = 0; U.t0e = NPOS / 64; U.t1b = 0; U.t1e = 0; U.qlat0 = qt * 128; U.sink0 = U.sink1 = 0.f;
        U.o0 = Oo + row0 * 1024 + hd * 64; U.o1 = U.o0 + 64;
        attn_unit<64, 0>(p, lds, U, wave, lane);
        conv_rounds(p, 0, cdone, cdone + 4, wave, lane); cdone += 4;
    }
    for (int u = blockIdx.x; u < 512; u += gridDim.x) {
        const int xq = u & 7, iq = u >> 3, b = xq >> 1, kvh = xq & 1, pr = iq >> 5, qt = iq & 31, hd = kvh * 4 + pr * 2;
        const size_t row0 = (size_t)TCTX + (size_t)b * SEQ + qt * 128;
        AttnUnit U; U.qstride = 512; U.ostride = 1024;
        U.q0 = QB + row0 * 512 + hd * 64; U.q1 = U.q0 + 64;
        U.k0 = U.k1 = KB + (size_t)(b * 2 + kvh) * NPOS * 64; U.v = VB + (size_t)(b * 2 + kvh) * NPOS * 64;
        const int lo = qt * 128 - 128 < 0 ? 0 : qt * 128 - 128, hi = qt * 128 + 256 > SEQ ? SEQ : qt * 128 + 256;
        U.t0b = 0; U.t0e = 4; U.t1b = 4 + lo / 64; U.t1e = 4 + hi / 64; U.qlat0 = qt * 128;
        U.sink0 = sink[hd] * LOG2E; U.sink1 = sink[hd + 1] * LOG2E;
        U.o0 = Oo + row0 * 1024 + 512 + hd * 64; U.o1 = U.o0 + 64;
        attn_unit<64, 1>(p, lds, U, wave, lane);
    }
    for (int u = blockIdx.x; u < 64; u += gridDim.x) {
        const int ty = u >> 5, b = (u >> 3) & 3, kvh = (u >> 2) & 1, pr = (u >> 1) & 1, qt = u & 1, hd = kvh * 4 + pr * 2;
        const size_t row0 = (size_t)b * LCTX + qt * 128;
        AttnUnit U; U.qstride = 512; U.ostride = 1024;
        U.q0 = (ty ? QB : QA) + row0 * 512 + hd * 64; U.q1 = U.q0 + 64;
        U.k0 = U.k1 = (ty ? KB : KA) + (size_t)(b * 2 + kvh) * NPOS * 64; U.v = (ty ? VB : VA) + (size_t)(b * 2 + kvh) * NPOS * 64;
        U.t0b = 0; U.t0e = 4; U.t1b = 0; U.t1e = 0; U.qlat0 = -100000;
        U.sink0 = sink[hd] * LOG2E; U.sink1 = sink[hd + 1] * LOG2E;
        U.o0 = Oo + row0 * 1024 + ty * 512 + hd * 64; U.o1 = U.o0 + 64;
        if (ty) attn_unit<64, 1>(p, lds, U, wave, lane); else attn_unit<64, 0>(p, lds, U, wave, lane);
    }
    conv_rounds(p, 0, cdone, crounds, wave, lane);
}
template <int AF>
__device__ __forceinline__ void ph_attn1(const Params& p, LAS uchar* lds, int wave, int lane) {
    uchar* big = p.ws + WS_BIG;
    const uchar *QC = big + L1_QC, *KC = big + L1_KC, *VC = big + L1_VC;
    bf16_t* Oo = (bf16_t*)(big + (AF ? L1_PO : L1_O));
    int cdone = 0; const int crounds = (CONV_T - conv_base(1) + (int)gridDim.x * 8 - 1) / ((int)gridDim.x * 8);
    for (int u = blockIdx.x; u < 1024; u += gridDim.x) {
        const int b = u >> 8, hd = u & 7, qt = (u >> 3) & 31;
        const size_t row0 = (size_t)TCTX + (size_t)b * SEQ + qt * 128;
        AttnUnit U; U.qstride = 1024; U.ostride = 1024;
        U.q0 = QC + row0 * 1024 + hd * 128; U.q1 = U.q0 + 64;
        U.k0 = KC + (size_t)(b * 16 + hd * 2) * NPOS * 64; U.k1 = U.k0 + (size_t)NPOS * 64; U.v = VC + (size_t)(b * 8 + hd) * NPOS * 128;
        U.t0b = 0; U.t0e = NPOS / 64; U.t1b = 0; U.t1e = 0; U.qlat0 = qt * 128; U.sink0 = U.sink1 = 0.f;
        U.o0 = Oo + row0 * 1024 + hd * 128; U.o1 = U.o0;
        attn_unit<128, 2, AF>(p, lds, U, wave, lane);
        if (!AF) { conv_rounds(p, 1, cdone, cdone + 2, wave, lane); cdone += 2; }
    }
    if (!AF) conv_rounds(p, 1, cdone, crounds, wave, lane);
}

template <int CTRL> __device__ __forceinline__ float dppf(float v) { return __uint_as_float((unsigned)__builtin_amdgcn_update_dpp(0, (int)__float_as_uint(v), CTRL, 0xf, 0xf, true)); }
#define rlf(v, l) __uint_as_float((unsigned)__builtin_amdgcn_readlane((int)__float_as_uint(v), (l)))
__device__ __forceinline__ float max8(float v) { v = fmaxf(v, dppf<0xB1>(v)); v = fmaxf(v, dppf<0x4E>(v)); v = fmaxf(v, dppf<0x141>(v)); return v; }
__device__ __forceinline__ float max64(float v) { v = max8(v); v = fmaxf(v, dppf<0x140>(v));
    const float a = rlf(v, 0), b = rlf(v, 16), c = rlf(v, 32), d = rlf(v, 48);
    return fmaxf(fmaxf(a, b), fmaxf(c, d)); }
__device__ __forceinline__ float sum64(float v) { v += dppf<0xB1>(v); v += dppf<0x4E>(v); v += dppf<0x141>(v); v += dppf<0x140>(v);
    return (rlf(v, 0) + rlf(v, 16)) + (rlf(v, 32) + rlf(v, 48)); }
__device__ __forceinline__ float ss16(const f32x4 (&v)[4]) {
    float s = 0.f;
#pragma unroll
    for (int i = 0; i < 4; ++i) s += v[i][0] * v[i][0] + v[i][1] * v[i][1] + v[i][2] * v[i][2] + v[i][3] * v[i][3];
    return sum64(s); }
constexpr int RT_PITCH = 2064;
template <int FAKE>
__device__ __forceinline__ void ph_postmix_route(const Params& p, LAS uchar* lds, int wave, int lane, int l, const bf16_t* PO, uchar* H2, int row_lo, float* xdummy) {
    const float* ng = p.in[6] + (size_t)l * 4 * DM;
    const float* mod = (const float*)(p.ws + WS_MOD) + (size_t)l * 5 * 6144;
    const bf16_t* RWt = (const bf16_t*)(p.ws + WS_RW) + (size_t)l * 64 * 1024;
    const float* rb = p.in[17] + l * 64;
    const int grp = blockIdx.x & 15;
    unsigned* cnt = (unsigned*)(p.ws + CNT_OFF + (FAKE ? CNT_SET : 0)) + (size_t)((l * 16 + grp) * 64) * 16;
    int* list = (int*)(p.ws + WS_LIST);
    float* slotw = (float*)(p.ws + WS_SLOTW);
    bf16_t* XB = (bf16_t*)(p.ws + WS_XB);
    LAS uchar* T = lds;
    LAS float* P = (LAS float*)(lds + 16 * RT_PITCH);
    bf16x8 wb[4][4];
#pragma unroll
    for (int ks = 0; ks < 4; ++ks)
#pragma unroll
        for (int nb = 0; nb < 4; ++nb) wb[ks][nb] = *(const bf16x8*)(RWt + (size_t)(nb * 16 + (lane & 15)) * 1024 + wave * 128 + ks * 32 + 8 * (lane >> 4));
    const float rbias = rb[lane];
    f32x4 g1v[4], g2v[4];
#pragma unroll
    for (int i = 0; i < 4; ++i) { const int c = 8 * lane + 512 * (i >> 1) + 4 * (i & 1); g1v[i] = ld4(ng + DM + c); g2v[i] = ld4(ng + 2 * DM + c); }
    const int ngroups = (TT - row_lo) / 16;
    for (int rg = blockIdx.x; rg < ngroups; rg += gridDim.x) {
        const int row0 = row_lo + rg * 16, mr = mod_row(row0);
        f32x4 y[2][4], x[2][4];
#pragma unroll
        for (int rr = 0; rr < 2; ++rr) {
            const int row = row0 + wave * 2 + rr;
            const float* xs = (row < TCTX) ? p.in[2] + (size_t)row * DM : p.in[0] + (size_t)(row - TCTX) * DM;
#pragma unroll
            for (int hf = 0; hf < 2; ++hf) { const int c = 8 * lane + 512 * hf;
                const u32x4 w = *(const u32x4*)(PO + (size_t)row * DM + c);
                y[rr][2 * hf] = (f32x4){bf_lo(w.x), bf_hi(w.x), bf_lo(w.y), bf_hi(w.y)}; y[rr][2 * hf + 1] = (f32x4){bf_lo(w.z), bf_hi(w.z), bf_lo(w.w), bf_hi(w.w)};
                if (l == 0) { x[rr][2 * hf] = ld4(xs + c); x[rr][2 * hf + 1] = ld4(xs + c + 4); }
                else { const u32x4 xw = *(const u32x4*)(XB + (size_t)row * DM + c);
                    x[rr][2 * hf] = (f32x4){bf_lo(xw.x), bf_hi(xw.x), bf_lo(xw.y), bf_hi(xw.y)}; x[rr][2 * hf + 1] = (f32x4){bf_lo(xw.z), bf_hi(xw.z), bf_lo(xw.w), bf_hi(xw.w)}; } }
        }
        f32x4 gt[4], sc[4], sh[4];
#pragma unroll
        for (int i = 0; i < 4; ++i) { const int c = 8 * lane + 512 * (i >> 1) + 4 * (i & 1);
            gt[i] = ld4(mod + mr * 6144 + 2048 + c); sh[i] = ld4(mod + mr * 6144 + 3072 + c); sc[i] = ld4(mod + mr * 6144 + 4096 + c); }
#pragma unroll
        for (int rr = 0; rr < 2; ++rr) {
            const int li = wave * 2 + rr, row = row0 + li;
            bf16_t* xd = FAKE ? (bf16_t*)xdummy + (size_t)row * DM : XB + (size_t)row * DM;
            const float rs1 = rsqrtf(ss16(y[rr]) * (1.0f / DM) + EPS);
#pragma unroll
            for (int i = 0; i < 4; ++i) { const int c = 8 * lane + 512 * (i >> 1) + 4 * (i & 1);
                x[rr][i] = x[rr][i] + gt[i] * (y[rr][i] * rs1 * g1v[i]); }
#pragma unroll
            for (int hf = 0; hf < 2; ++hf) { const f32x4 &xa = x[rr][2 * hf], &xb_ = x[rr][2 * hf + 1];
                u32x4 w; w.x = cvt_pk(xa[0], xa[1]); w.y = cvt_pk(xa[2], xa[3]); w.z = cvt_pk(xb_[0], xb_[1]); w.w = cvt_pk(xb_[2], xb_[3]);
                *(u32x4*)(xd + 8 * lane + 512 * hf) = w; }
            const float rs2 = rsqrtf(ss16(x[rr]) * (1.0f / DM) + EPS);
#pragma unroll
            for (int hf = 0; hf < 2; ++hf) { const int c = 8 * lane + 512 * hf;
                const f32x4 h0 = x[rr][2 * hf] * rs2 * g2v[2 * hf] * (1.0f + sc[2 * hf]) + sh[2 * hf], h1 = x[rr][2 * hf + 1] * rs2 * g2v[2 * hf + 1] * (1.0f + sc[2 * hf + 1]) + sh[2 * hf + 1];
                u32x4 w; w.x = cvt_pk(h0[0], h0[1]); w.y = cvt_pk(h0[2], h0[3]); w.z = cvt_pk(h1[0], h1[1]); w.w = cvt_pk(h1[2], h1[3]);
                { u32x2 wq; wq.x = pk_fp8x4(h0[0] * H2_QS, h0[1] * H2_QS, h0[2] * H2_QS, h0[3] * H2_QS); wq.y = pk_fp8x4(h1[0] * H2_QS, h1[1] * H2_QS, h1[2] * H2_QS, h1[3] * H2_QS);
                  *(u32x2*)(H2 + (size_t)row * DM + c) = wq; }
                *(LAS u32x4*)(T + li * RT_PITCH + c * 2) = w; }
        }
        __syncthreads();
        f32x4 acc[4];
#pragma unroll
        for (int nb = 0; nb < 4; ++nb) acc[nb] = (f32x4){0.f, 0.f, 0.f, 0.f};
#pragma unroll
        for (int ks = 0; ks < 4; ++ks) {
            const bf16x8 a = *(const LAS bf16x8*)(T + (lane & 15) * RT_PITCH + (wave * 128 + ks * 32 + 8 * (lane >> 4)) * 2);
#pragma unroll
            for (int nb = 0; nb < 4; ++nb) acc[nb] = __builtin_amdgcn_mfma_f32_16x16x32_bf16(a, wb[ks][nb], acc[nb], 0, 0, 0);
        }
#pragma unroll
        for (int nb = 0; nb < 4; ++nb)
#pragma unroll
            for (int r = 0; r < 4; ++r) P[(wave * 16 + (lane >> 4) * 4 + r) * 64 + nb * 16 + (lane & 15)] = acc[nb][r];
        __syncthreads();
#pragma unroll
        for (int rr = 0; rr < 2; ++rr) {
            const int li = wave * 2 + rr, row = row0 + li;
            float lg = 0.f;
#pragma unroll
            for (int w = 0; w < 8; ++w) lg += P[(w * 16 + li) * 64 + lane];
            const float score = 1.0f / (1.0f + __expf(-lg));
            const float sel = score + rbias;
            const float m1 = max8(sel);
            const unsigned long long bal = __ballot(sel == m1);
            const unsigned gb = (unsigned)(bal >> (lane & 56)) & 0xFFu;
            const int first = __builtin_ctz(gb | 0x100u);
            const float m2 = max8(((lane & 7) == first) ? -INFINITY : sel);
            const float gs = m1 + m2;
            const int g = lane >> 3; int rank = 0;
#pragma unroll
            for (int gp = 0; gp < 8; ++gp) { const float o = rlf(gs, gp * 8); rank += ((o > gs) || (o == gs && gp < g)) ? 1 : 0; }
            float v = (rank < 4) ? sel : -1e30f;
            bool chosen = false;
#pragma unroll
            for (int it = 0; it < 8; ++it) {
                const float mx = max64(v);
                const unsigned long long b2 = __ballot(v == mx);
                const int f = __builtin_ctzll(b2);
                if (lane == f) { chosen = true; v = -INFINITY; }
            }
            const float ssum = sum64(chosen ? score : 0.f);
            const unsigned long long cb = __ballot(chosen);
            if (chosen) {
                const int k = __popcll(cb & ((1ull << lane) - 1ull));
                const int slot = row * 8 + k;
                const unsigned pos = atomicAdd(&cnt[lane * 16], 1u);
                list[(size_t)(lane * 16 + grp) * LCAP + pos] = slot;
                slotw[slot] = score / ssum * 2.5f;
            }
        }
        __syncthreads();
    }
}

__device__ __forceinline__ int moe_prefix(const Params& p, LAS int* pre, LAS int* seg, int l, int row_lo) {
    const unsigned* cnt = (const unsigned*)(p.ws + CNT_OFF) + (size_t)(l * 16 * 64) * 16;
    __syncthreads();
    if (threadIdx.x < 64) {
        const int e = threadIdx.x; int acc = 0;
        unsigned c16[16];
#pragma unroll
        for (int g = 0; g < 16; ++g) c16[g] = cnt[(size_t)(g * 64 + e) * 16];
#pragma unroll
        for (int g = 0; g < 16; ++g) { seg[e * 17 + g] = acc; acc += (int)c16[g]; }
        seg[e * 17 + 16] = acc;
        const int tl = (acc + 127) >> 7; int incl = tl;
#pragma unroll
        for (int d = 1; d < 64; d <<= 1) { const int o = __shfl_up(incl, d); if (e >= d) incl += o; }
        pre[e] = incl - tl;
        if (e == 63) { pre[64] = incl; pre[65] = incl + ((TT - row_lo) >> 7); }
    }
    __syncthreads();
    return pre[65];
}
__device__ __forceinline__ void moe_tile_rows(const Params& p, LAS int* pre, LAS int* seg, LAS int* sl, int l, int row_lo, int mg, int& e_out, int& nvalid) {
    const int* list = (const int*)(p.ws + WS_LIST);
    int e = 0;
    for (int q = 1; q <= 64; ++q) e = (pre[q] <= mg) ? q : e;
    const int lm = mg - pre[e], count = (e < 64) ? seg[e * 17 + 16] : (TT - row_lo);
    const int nv = (count - lm * 128) < 128 ? (count - lm * 128) : 128;
    __syncthreads();
    if (threadIdx.x < 128) {
        int idx = lm * 128 + (int)threadIdx.x; if (idx >= count) idx = count - 1;
        int v;
        if (e < 64) { int g = 0;
#pragma unroll
            for (int q = 1; q < 16; ++q) g = (seg[e * 17 + q] <= idx) ? q : g;
            v = list[(size_t)(e * 16 + g) * LCAP + (idx - seg[e * 17 + g])]; }
        else v = NSLOT_R + row_lo + idx;
        sl[threadIdx.x] = v;
    }
    __syncthreads();
    e_out = e; nvalid = nv;
}
template <int FAKE>
__device__ __forceinline__ void ph_moe(const Params& p, LAS uchar* lds, int wave, int lane, int l, const uchar* H2, int row_lo) {
    constexpr int ST1 = 40960, ST2 = 16384, P2OFF = 65536;
    LAS int* pre = (LAS int*)(lds + LDS_SMALL); LAS int* sl = pre + 128; LAS int* seg = pre + 256;
    uchar* Yk = p.ws + WS_BIG + BIG_YK; uchar* Ysh = p.ws + WS_BIG + BIG_YSH;
    uchar* trash = p.ws + WS_TRASH;
    const float* slotw = (const float*)(p.ws + WS_SLOTW);
    const int r32 = lane & 31, h = lane >> 5, wm = wave >> 2, wn = wave & 3, sw = (r32 >> 2) & 3;
    const int c0 = ((2 * h) ^ sw) << 4, c1 = ((2 * h + 1) ^ sw) << 4;
    const int ntile = moe_prefix(p, pre, seg, l, row_lo);
    for (int u = blockIdx.x; u < ntile; u += gridDim.x) {
        int e, nv; moe_tile_rows(p, pre, seg, sl, l, row_lo, u, e, nv);
        const uchar* W13 = p.ws + WS_WE + (size_t)((FAKE & 2) ? 0 : e) * WE_STRIDE;
        const uchar* W2 = W13 + (size_t)512 * 1024;
        const uchar* ap; const uchar* bp[4];
        { const int s = sl[wave * 16 + (lane >> 2)]; const int trow = (FAKE & 4) ? (row_lo + ((u * 128 + wave * 16 + (lane >> 2)) % (TT - row_lo))) : (s < NSLOT_R) ? (s >> 3) : (s - NSLOT_R);
          ap = H2 + (size_t)trow * DM + dma_chunk(lane) * 16; }
#pragma unroll
        for (int i = 0; i < 4; ++i) bp[i] = W13 + (size_t)((wave * 4 + i) * 16 + (lane >> 2)) * 1024 + dma_chunk(lane) * 16;
        f32x16 acc1[4][2]; zero_acc<4>(acc1);
#define P1_ISSUE(stg, kb) do { dma16(ap + (kb), (stg) + wave * 1024); _Pragma("unroll") for (int i_ = 0; i_ < 4; ++i_) dma16(bp[i_] + (kb), (stg) + 8192 + (wave * 4 + i_) * 1024); } while (0)
        P1_ISSUE(lds, 0); P1_ISSUE(lds + ST1, 64);
        const bool upper = wave >= 4;
        VMWAIT(5);
        if (upper) BAR_RAW();
#define LD8(dst_, base_) do { const i32x4 lo_ = *(const LAS i32x4*)((base_) + c0), hi_ = *(const LAS i32x4*)((base_) + c1); \
            dst_ = __builtin_shufflevector(lo_, hi_, 0, 1, 2, 3, 4, 5, 6, 7); } while (0)
#define MFMA8(a_, b_, c_) __builtin_amdgcn_mfma_scale_f32_32x32x64_f8f6f4(a_, b_, c_, 0, 0, 0, 0, 0, 0)
        { int cur = 0, nxt = 2;
          const int a_base = (wm * 64 + r32) * 64, b_base = 8192 + (wn * 128 + r32) * 64;
          for (int kt = 0; kt < 16; ++kt) {
            BAR_RAW();
            if (kt + 2 < 16) P1_ISSUE(lds + nxt * ST1, (kt + 2) * 64);
            const LAS uchar* st = lds + cur * ST1;
            i32x8 a[2], b[4];
            LD8(a[0], st + a_base); LD8(a[1], st + a_base + 2048);
#pragma unroll
            for (int jn = 0; jn < 4; ++jn) LD8(b[jn], st + b_base + jn * 2048);
            if (kt + 2 < 16) VLWAIT(5); else VLWAIT(0);
            __builtin_amdgcn_sched_barrier(0);
            BAR_RAW();
            __builtin_amdgcn_sched_barrier(0);
            __builtin_amdgcn_s_setprio(1);
#pragma unroll
            for (int jn = 0; jn < 4; ++jn) { acc1[jn][0] = MFMA8(b[jn], a[0], acc1[jn][0]); acc1[jn][1] = MFMA8(b[jn], a[1], acc1[jn][1]); }
            __builtin_amdgcn_s_setprio(0);
            __builtin_amdgcn_sched_barrier(0);
            cur = (cur == 2) ? 0 : cur + 1; nxt = (nxt == 2) ? 0 : nxt + 1;
          } }
        if (!upper) BAR_RAW();
#undef P1_ISSUE
        asm volatile("" ::: "memory");
        __builtin_amdgcn_s_barrier();
        asm volatile("" ::: "memory");
        uchar* dst[2]; float wgt[2];
#pragma unroll
        for (int im = 0; im < 2; ++im) { const int ri = wm * 64 + im * 32 + r32, s = sl[ri];
            wgt[im] = (s < NSLOT_R) ? slotw[s] : 1.0f;
            dst[im] = (ri < nv && !(FAKE & 1)) ? (((s < NSLOT_R) ? Yk + (size_t)s * DM : Ysh + (size_t)(s - NSLOT_R) * DM) + wn * 64) : trash + wn * 64; }
        const uchar* bp2[2];
#pragma unroll
        for (int i = 0; i < 2; ++i) bp2[i] = W2 + (size_t)((wave * 2 + i) * 16 + (lane >> 2)) * 256 + dma_chunk(lane) * 16;
#define P2_ISSUE(t_) do { const int t__ = (t_); const size_t o__ = (size_t)(t__ >> 2) * 65536 + (size_t)(t__ & 3) * 64; \
        dma16(bp2[0] + o__, lds + P2OFF + (t__ & 3) * ST2 + (wave * 2) * 1024); dma16(bp2[1] + o__, lds + P2OFF + (t__ & 3) * ST2 + (wave * 2 + 1) * 1024); } while (0)
        P2_ISSUE(0); P2_ISSUE(1); P2_ISSUE(2);
#pragma unroll
        for (int im = 0; im < 2; ++im) {
            const int row = wm * 64 + im * 32 + r32;
#pragma unroll
            for (int hh = 0; hh < 2; ++hh) { f32x16 o;
                constexpr float DQ = 1.0f / (H2_QS * W13_QS);
#pragma unroll
                for (int r = 0; r < 16; ++r) { const float a = acc1[2 * hh][im][r] * DQ, b = acc1[2 * hh + 1][im][r] * (DQ * HMID_QS); o[r] = a / (1.0f + __expf(-a)) * b; }
                unsigned q4[4];
#pragma unroll
                for (int rq = 0; rq < 4; ++rq) q4[rq] = pk_fp8x4(o[4 * rq], o[4 * rq + 1], o[4 * rq + 2], o[4 * rq + 3]);
                const auto ra = __builtin_amdgcn_permlane32_swap(q4[0], q4[2], false, false);
                const auto rb = __builtin_amdgcn_permlane32_swap(q4[1], q4[3], false, false);
                u32x4 w; w.x = ra[0]; w.y = ra[1]; w.z = rb[0]; w.w = rb[1];
                *(LAS u32x4*)(lds + wn * 8192 + row * 64 + (((2 * hh + h) ^ sw) << 4)) = w;
            }
        }
        f32x16 acc2[2][2]; zero_acc<2>(acc2);
        asm volatile("" : "+v"(wgt[0]), "+v"(wgt[1]));
        asm volatile("s_waitcnt lgkmcnt(0)" ::: "memory");
        { const int a_base = (wm * 64 + r32) * 64, b_base = (wn * 64 + r32) * 64;
          constexpr float DQ2 = 1.0f / (HMID_QS * W2_QS);
          for (int t = 0; t < 16; ++t) {
            const int nt = t >> 2, kt = t & 3;
            if (!(nt > 0 && kt < 3)) { if (t + 2 < 16) VMWAIT(4); else if (t + 1 < 16) VMWAIT(2); else VMWAIT(0); }
            __builtin_amdgcn_s_barrier();
            asm volatile("" ::: "memory");
            if (t + 3 < 16) P2_ISSUE(t + 3);
            const LAS uchar* st = lds + P2OFF + (t & 3) * ST2;
            const LAS uchar* ha = lds + kt * 8192;
            i32x8 a0, a1, b0, b1;
            LD8(a0, ha + a_base); LD8(a1, ha + a_base + 2048);
            LD8(b0, st + b_base); LD8(b1, st + b_base + 2048);
            acc2[0][0] = MFMA8(b0, a0, acc2[0][0]); acc2[0][1] = MFMA8(b0, a1, acc2[0][1]);
            acc2[1][0] = MFMA8(b1, a0, acc2[1][0]); acc2[1][1] = MFMA8(b1, a1, acc2[1][1]);
            if (kt == 3) {
                VMWAIT(0);
#pragma unroll
                for (int im = 0; im < 2; ++im)
#pragma unroll
                    for (int jn = 0; jn < 2; ++jn) {
                        const f32x16& v = acc2[jn][im]; const float w = wgt[im] * DQ2;
                        unsigned q4[4];
#pragma unroll
                        for (int rq = 0; rq < 4; ++rq) q4[rq] = pk_fp8x4(v[4 * rq] * w, v[4 * rq + 1] * w, v[4 * rq + 2] * w, v[4 * rq + 3] * w);
                        const auto ra = __builtin_amdgcn_permlane32_swap(q4[0], q4[2], false, false);
                        const auto rb = __builtin_amdgcn_permlane32_swap(q4[1], q4[3], false, false);
                        u32x4 q; q.x = ra[0]; q.y = ra[1]; q.z = rb[0]; q.w = rb[1];
                        *(u32x4*)(dst[im] + nt * 256 + jn * 32 + 16 * h) = q;
                    }
                zero_acc<2>(acc2);
            }
          } }
#undef LD8
#undef MFMA8
#undef P2_ISSUE
    }
}

struct CombRow { u32x2 ysh[2]; u32x2 yk[8][2]; u32x4 x[2]; };
__device__ __forceinline__ void comb_load(CombRow& R, const uchar* Yk, const uchar* Ysh, const bf16_t* xp, int row, int lane) {
#pragma unroll
    for (int hf = 0; hf < 2; ++hf) { const int c = 8 * lane + 512 * hf;
        R.ysh[hf] = __builtin_nontemporal_load((const u32x2*)(Ysh + (size_t)row * DM + c));
#pragma unroll
        for (int k = 0; k < 8; ++k) R.yk[k][hf] = __builtin_nontemporal_load((const u32x2*)(Yk + ((size_t)row * 8 + k) * DM + c));
        R.x[hf] = *(const u32x4*)(xp + c); }
}
__device__ __forceinline__ void acc_bf8(f32x4& a, f32x4& b, const u32x2 w) { a += fp8x4_f32(w.x); b += fp8x4_f32(w.y); }
template <bool LAST, int FAKE>
__device__ __forceinline__ void ph_combine(const Params& p, int wave, int lane, int l, int row_lo, float* xdummy) {
    const int nw = gridDim.x * 8, gw = blockIdx.x * 8 + wave;
    const float* ng = p.in[6] + (size_t)l * 4 * DM;
    const float* mod = (const float*)(p.ws + WS_MOD) + (size_t)l * 5 * 6144;
    const uchar* Yk = p.ws + WS_BIG + BIG_YK; const uchar* Ysh = p.ws + WS_BIG + BIG_YSH;
    bf16_t* XB = (bf16_t*)(p.ws + WS_XB);
    bf16_t* Hn = (bf16_t*)(p.ws + WS_BIG + L1_H);
    {
        const int r_lo = row_lo + (int)((long long)gw * (TT - row_lo) / nw), r_hi = row_lo + (int)((long long)(gw + 1) * (TT - row_lo) / nw);
        int mr = -1;
        f32x4 g3[4], gt[4];
#pragma unroll
        for (int i = 0; i < 4; ++i) { const int c = 8 * lane + 512 * (i >> 1) + 4 * (i & 1); g3[i] = ld4(ng + 3 * DM + c); gt[i] = g3[i]; }
#pragma unroll 1
        for (int row = r_lo; row < r_hi; ++row) {
            {
                if (mod_row(row) != mr) { mr = mod_row(row);
#pragma unroll
                    for (int i = 0; i < 4; ++i) { const int c = 8 * lane + 512 * (i >> 1) + 4 * (i & 1); gt[i] = ld4(mod + mr * 6144 + 5120 + c); } }
                CombRow C;
                comb_load(C, Yk, Ysh, XB + (size_t)row * DM, row, lane);
                f32x4 y[4];
#pragma unroll
                for (int hf = 0; hf < 2; ++hf) { y[2 * hf] = (f32x4){0.f, 0.f, 0.f, 0.f}; y[2 * hf + 1] = (f32x4){0.f, 0.f, 0.f, 0.f};
                    acc_bf8(y[2 * hf], y[2 * hf + 1], C.ysh[hf]);
#pragma unroll
                    for (int k = 0; k < 8; ++k) acc_bf8(y[2 * hf], y[2 * hf + 1], C.yk[k][hf]); }
                const float rs = rsqrtf(ss16(y) * (1.0f / DM) + EPS);
                f32x4 x[4];
#pragma unroll
                for (int hf = 0; hf < 2; ++hf) { const u32x4 xw = C.x[hf];
                    x[2 * hf] = (f32x4){bf_lo(xw.x), bf_hi(xw.x), bf_lo(xw.y), bf_hi(xw.y)} + gt[2 * hf] * (y[2 * hf] * rs * g3[2 * hf]);
                    x[2 * hf + 1] = (f32x4){bf_lo(xw.z), bf_hi(xw.z), bf_lo(xw.w), bf_hi(xw.w)} + gt[2 * hf + 1] * (y[2 * hf + 1] * rs * g3[2 * hf + 1]); }
                if (LAST) {
                    float* xq = FAKE ? xdummy + (size_t)row * DM : p.out + (size_t)(row - TCTX) * DM;
#pragma unroll
                    for (int i = 0; i < 4; ++i) *(f32x4*)(xq + 8 * lane + 512 * (i >> 1) + 4 * (i & 1)) = x[i];
                } else {
                    bf16_t* xq = FAKE ? (bf16_t*)xdummy + (size_t)row * DM : XB + (size_t)row * DM;
#pragma unroll
                    for (int hf = 0; hf < 2; ++hf) { u32x4 w; w.x = cvt_pk(x[2 * hf][0], x[2 * hf][1]); w.y = cvt_pk(x[2 * hf][2], x[2 * hf][3]);
                        w.z = cvt_pk(x[2 * hf + 1][0], x[2 * hf + 1][1]); w.w = cvt_pk(x[2 * hf + 1][2], x[2 * hf + 1][3]);
                        *(u32x4*)(xq + 8 * lane + 512 * hf) = w; }
                }
                if (!LAST) {
                    const float rs2 = rsqrtf(ss16(x) * (1.0f / DM) + EPS);
#pragma unroll
                    for (int hf = 0; hf < 2; ++hf) { const int c = 8 * lane + 512 * hf;
                        const f32x4 h0 = x[2 * hf] * rs2 * ld4(ng + 4 * DM + c) * (1.0f + ld4(mod + 5 * 6144 + mr * 6144 + 1024 + c)) + ld4(mod + 5 * 6144 + mr * 6144 + c);
                        const f32x4 h1 = x[2 * hf + 1] * rs2 * ld4(ng + 4 * DM + c + 4) * (1.0f + ld4(mod + 5 * 6144 + mr * 6144 + 1024 + c + 4)) + ld4(mod + 5 * 6144 + mr * 6144 + c + 4);
                        u32x4 w; w.x = cvt_pk(h0[0], h0[1]); w.y = cvt_pk(h0[2], h0[3]); w.z = cvt_pk(h1[0], h1[1]); w.w = cvt_pk(h1[2], h1[3]);
                        *(u32x4*)(Hn + (size_t)row * DM + c) = w; }
                }
            }
        }
    }
}

__device__ __forceinline__ void ph_l2probe(const uchar* base) {
    const u32x4* src = (const u32x4*)base; u32x4 acc = {0u, 0u, 0u, 0u};
    for (int rep = 0; rep < 64; ++rep)
        for (int i = threadIdx.x; i < (2 << 20) / 16; i += 512 * 8) {
#pragma unroll
            for (int j = 0; j < 8; ++j) { const u32x4 v = src[i + j * 512]; acc.x ^= v.x; acc.y ^= v.y; acc.z ^= v.z; acc.w ^= v.w; }
        }
    asm volatile("" :: "v"(acc));
}
__device__ __forceinline__ void ph_dump(const Params& p) {
    const bf16_t* src = (const bf16_t*)(p.ws + p.dbg_off); const size_t n = p.dbg_bytes / 2, NO = (size_t)TLAT * DM;
    for (size_t i = (size_t)blockIdx.x * 512 + threadIdx.x; i < NO; i += (size_t)gridDim.x * 512) {
        float a = 0.f;
        for (size_t j = i; j < n; j += NO) a += __uint_as_float((unsigned)src[j] << 16);
        p.out[i] = a;
    }
}
extern __shared__ __attribute__((aligned(16))) uchar smem_raw[];
__global__ void __launch_bounds__(512, 2) fwd(Params p) {
    LAS uchar* lds = (LAS uchar*)smem_raw;
    const int lane = threadIdx.x & 63, wave = __builtin_amdgcn_readfirstlane(threadIdx.x >> 6);
    const int lo = p.ph_lo, hi = p.ph_hi;
    XcdBarrier bar; bar.bar = (unsigned*)(p.ws + p.bar_off); bar.x = 0; bar.st = (volatile LAS unsigned*)(lds + LDS_BAR);
    if (hi - lo > 1) {
        if (threadIdx.x == 0) { *(LAS u32x4*)(lds + LDS_BAR) = (u32x4){0u, 0u, 0u, 0u}; }
        __syncthreads();
        bar = xcd_barrier_post((unsigned*)(p.ws + p.bar_off), (volatile LAS unsigned*)(lds + LDS_BAR));
#ifdef EXTRA_FIRST_BARRIER
        xcd_barrier(bar);
#endif
    }
#ifndef PHASE_MASK
#define PHASE_MASK 0xFFFF
#endif
#define IN(k) (((PHASE_MASK >> (k)) & 1) && lo <= (k) && (k) < hi)
#define SEAM(k) do { if (IN(k) && IN((k) + 1)) xcd_barrier(bar); } while (0)
#ifndef REPEAT_MASK
#define REPEAT_MASK 0
#endif
#define REP(k) if (((REPEAT_MASK >> (k)) & 1) && IN(k)) xcd_barrier(bar); if (((REPEAT_MASK >> (k)) & 1) && IN(k))
    uchar* big = p.ws + WS_BIG;
    if (IN(0)) ph_prologue(p, wave, lane);
    REP(0) ph_prologue(p, wave, lane);
    SEAM(0);
    if (IN(1)) ph_h0(p, wave, lane);
#ifdef PROBE_L2_WS
    if (IN(1)) ph_l2probe(p.ws + WS_WD);
#endif
#ifdef PROBE_L2_IN
    if (IN(1)) ph_l2probe((const uchar*)p.in[18]);
#endif
    REP(1) ph_h0(p, wave, lane);
    SEAM(1);
    if (IN(2)) ph_inproj0(p, lds, wave, lane);
    REP(2) ph_inproj0(p, lds, wave, lane);
    SEAM(2);
    if (IN(3)) ph_attn0(p, lds, wave, lane);
    REP(3) ph_attn0(p, lds, wave, lane);
    SEAM(3);
    if (IN(4)) ph_outproj<2>(p, lds, wave, lane, (const bf16_t*)(big + L0_ACT), (const bf16_t*)(p.ws + WS_WD + WD_ABOUT), (bf16_t*)(big + L0_PO), 0);
    REP(4) ph_outproj<2>(p, lds, wave, lane, (const bf16_t*)(big + L0_ACT), (const bf16_t*)(p.ws + WS_WD + WD_ABOUT), (bf16_t*)(big + L0_PO), 0);
    SEAM(4);
#ifdef ROW_FAKE
    if (IN(5)) { ph_postmix_route<1>(p, lds, wave, lane, 0, (const bf16_t*)(big + L0_PO), big + L0_H2, 0, (float*)big); xcd_barrier(bar); }
#endif
    if (IN(5)) ph_postmix_route<0>(p, lds, wave, lane, 0, (const bf16_t*)(big + L0_PO), big + L0_H2, 0, nullptr);
    SEAM(5);
#ifdef MOE_FAKE
    if (IN(6)) { ph_moe<MOE_FAKE>(p, lds, wave, lane, 0, big + L0_H2, 0); xcd_barrier(bar); }
#endif
    if (IN(6)) ph_moe<0>(p, lds, wave, lane, 0, big + L0_H2, 0);
    SEAM(6);
#ifdef COMB_FAKE
    if (IN(8)) { ph_combine<false, 1>(p, wave, lane, 0, 0, (float*)(p.ws + WS_WE)); xcd_barrier(bar); }
#endif
    if (IN(8)) ph_combine<false, 0>(p, wave, lane, 0, 0, nullptr);
    SEAM(8);
    if (IN(9)) ph_inproj1(p, lds, wave, lane);
    REP(9) ph_inproj1(p, lds, wave, lane);
    SEAM(9);
#ifdef ATT_FAKE
    if (IN(10)) { ph_attn1<ATT_FAKE>(p, lds, wave, lane); xcd_barrier(bar); }
#endif
    if (IN(10)) ph_attn1<0>(p, lds, wave, lane);
    SEAM(10);
    if (IN(11)) ph_outproj<4>(p, lds, wave, lane, (const bf16_t*)(big + L1_O), (const bf16_t*)(p.ws + WS_WD + WD_COUT), (bf16_t*)(big + L1_PO), 4);
    REP(11) ph_outproj<4>(p, lds, wave, lane, (const bf16_t*)(big + L1_O), (const bf16_t*)(p.ws + WS_WD + WD_COUT), (bf16_t*)(big + L1_PO), 4);
    SEAM(11);
#ifdef ROW_FAKE
    if (IN(12)) { ph_postmix_route<1>(p, lds, wave, lane, 1, (const bf16_t*)(big + L1_PO), big + L1_H2, TCTX, (float*)big); xcd_barrier(bar); }
#endif
    if (IN(12)) ph_postmix_route<0>(p, lds, wave, lane, 1, (const bf16_t*)(big + L1_PO), big + L1_H2, TCTX, nullptr);
    SEAM(12);
#ifdef MOE_FAKE
    if (IN(13)) { ph_moe<MOE_FAKE>(p, lds, wave, lane, 1, big + L1_H2, TCTX); xcd_barrier(bar); }
#endif
    if (IN(13)) ph_moe<0>(p, lds, wave, lane, 1, big + L1_H2, TCTX);
    SEAM(13);
#ifdef COMB_FAKE
    if (IN(15)) { ph_combine<true, 1>(p, wave, lane, 1, TCTX, (float*)(p.ws + WS_WE)); xcd_barrier(bar); }
#endif
    if (IN(15)) ph_combine<true, 0>(p, wave, lane, 1, TCTX, nullptr);
    if (lo == 16) ph_dump(p);
#undef IN
#undef SEAM
}

extern "C" void kernel_launch(void* const* d_in, const int* in_sizes, int n_in, void* d_out, int out_size, void* d_ws, size_t ws_size, hipStream_t stream) {
    static int grid = 0;
    if (grid == 0) {
        if (n_in != 24 || out_size != TLAT * DM || ws_size < WS_TOTAL) { fprintf(stderr, "kernel_launch: unexpected shapes or workspace (%zu < %zu)\n", ws_size, (size_t)WS_TOTAL); grid = -1; return; }
        int dev = 0, cus = 0;
        if (hipGetDevice(&dev) != hipSuccess || hipDeviceGetAttribute(&cus, hipDeviceAttributeMultiprocessorCount, dev) != hipSuccess || cus < 1) { grid = -1; return; }
        if (hipFuncSetAttribute((const void*)fwd, hipFuncAttributeMaxDynamicSharedMemorySize, LDS_BYTES) != hipSuccess) { fprintf(stderr, "kernel_launch: hipFuncSetAttribute failed\n"); grid = -1; return; }
        int per_cu = 0;
        if (hipOccupancyMaxActiveBlocksPerMultiprocessor(&per_cu, (const void*)fwd, 512, LDS_BYTES) != hipSuccess || per_cu < 1) { fprintf(stderr, "kernel_launch: occupancy query says %d\n", per_cu); (void)hipGetLastError(); }
        grid = cus & ~7;
    }
    if (grid < 0) return;
    (void)hipMemsetAsync(d_ws, 0, CTL_BYTES, stream);
    Params p{};
    for (int i = 0; i < 24; ++i) p.in[i] = (const float*)d_in[i];
    p.out = (float*)d_out; p.ws = (uchar*)d_ws;
#if defined(DBG_K)
#ifndef DBG_SKIP
#define DBG_SKIP 0
#endif
    for (int k = 0; k <= DBG_K; ++k) { if ((DBG_SKIP >> k) & 1) continue; p.ph_lo = k; p.ph_hi = k + 1; hipLaunchKernelGGL(fwd, dim3(grid), dim3(512), LDS_BYTES, stream, p); }
    p.ph_lo = 16; p.ph_hi = 17; p.dbg_off = (size_t)(DBG_OFF); p.dbg_bytes = (size_t)(DBG_BYTES);
    hipLaunchKernelGGL(fwd, dim3(grid), dim3(512), LDS_BYTES, stream, p);
#elif N_LAUNCH_PER_PHASE
    for (int k = 0; k < 16; ++k) { p.ph_lo = k; p.ph_hi = k + 1; hipLaunchKernelGGL(fwd, dim3(grid), dim3(512), LDS_BYTES, stream, p); }
#elif defined(SEAM_MASK)
    { int lo = 0, li = 0;
      for (int k = 0; k < 16; ++k) if (k == 15 || !((SEAM_MASK >> k) & 1)) { p.ph_lo = lo; p.ph_hi = k + 1; p.bar_off = (size_t)li * 16384; ++li; lo = k + 1;
          hipLaunchKernelGGL(fwd, dim3(grid), dim3(512), LDS_BYTES, stream, p); } }
#else
    p.ph_lo = 0; p.ph_hi = 16;
    hipLaunchKernelGGL(fwd, dim3(grid), dim3(512), LDS_BYTES, stream, p);
#endif
}
```
